# Optimizing an MI355X kernel written in HIP

```python
import jax, jax.numpy as jnp
from jax import lax
import numpy as np

D_MODEL = 2048
BATCH = 2
SEQ = 4096
DEPTH = 1

N_META = 16
HEAD_DIM = 128
FOX_HEADS = 8
SB_HEADS = 8
FOX_WIDTH = FOX_HEADS * HEAD_DIM
SB_WIDTH = SB_HEADS * HEAD_DIM
D_FF = 5632
Q_BLOCK = 128
RMS_EPS = 1e-6
FFN_RESIDUAL_WEIGHT = 0.5
FORGET_BIAS_INIT = 3.0

IN_SIZES = [FOX_WIDTH, FOX_WIDTH, FOX_WIDTH, FOX_HEADS,
            SB_WIDTH, SB_WIDTH, SB_WIDTH,
            D_MODEL, D_MODEL]
IN_PROJ_WIDTH = sum(IN_SIZES)
IN_SPLIT_POINTS = [int(v) for v in np.cumsum(IN_SIZES)[:-1]]

kernel_name = "hybrid_fox_stickbreak_macaron"


def _rmsnorm(x, gain):
    x32 = x.astype(jnp.float32)
    y = x32 * lax.rsqrt(jnp.mean(x32 * x32, axis=-1, keepdims=True) + RMS_EPS)
    return (y * gain.astype(jnp.float32)).astype(x.dtype)


def _swiglu(x, w_gate, w_up, w_down):
    return (jax.nn.silu(x @ w_gate) * (x @ w_up)) @ w_down


def _query_blocks(total_len):
    blocks = [(0, N_META)]
    start = N_META
    while start < total_len:
        end = min(start + Q_BLOCK, total_len)
        blocks.append((start, end))
        start = end
    return blocks


def _fox_attention(q, k, v, log_f_cum):
    L = q.shape[1]
    scale = HEAD_DIM ** -0.5
    outs = []
    for q0, q1 in _query_blocks(L):
        qb, kb, vb = q[:, q0:q1], k[:, :q1], v[:, :q1]
        logits = jnp.einsum('bqhd,bkhd->bhqk', qb, kb).astype(jnp.float32) * scale
        decay = log_f_cum[:, :, q0:q1, None] - log_f_cum[:, :, None, :q1]
        t = jnp.arange(q0, q1)[:, None]
        s = jnp.arange(q1)[None, :]
        logits = jnp.where(s <= t, logits + decay, -jnp.inf)
        p = jax.nn.softmax(logits, axis=-1)
        outs.append(jnp.einsum('bhqk,bkhd->bqhd', p.astype(vb.dtype), vb))
    return jnp.concatenate(outs, axis=1)


def _stick_breaking_attention(q, k, v):
    L = q.shape[1]
    scale = HEAD_DIM ** -0.5
    outs = []
    for q0, q1 in _query_blocks(L):
        qb, kb, vb = q[:, q0:q1], k[:, :q1], v[:, :q1]
        z = jnp.einsum('bqhd,bkhd->bhqk', qb, kb).astype(jnp.float32) * scale
        t = jnp.arange(q0, q1)[:, None]
        s = jnp.arange(q1)[None, :]
        strict = s < t
        log_beta = jax.nn.log_sigmoid(z)
        log_one_minus = jnp.where(strict, log_beta - z, 0.0)
        later = lax.cumsum(log_one_minus, axis=3, reverse=True) - log_one_minus
        w = jnp.where(strict, jnp.exp(log_beta + later), 0.0)
        outs.append(jnp.einsum('bhqk,bkhd->bqhd', w.astype(vb.dtype), vb))
    return jnp.concatenate(outs, axis=1)


def _hybrid_mixer(xn, w_in, b_forget, fox_q_norm, fox_k_norm, w_branch_fox, w_branch_sb, w_out):
    B, L, _ = xn.shape
    proj = xn @ w_in
    fq, fk, fv, f_logit, sq, sk, sv, g_fox, g_sb = jnp.split(proj, IN_SPLIT_POINTS, axis=-1)
    heads = lambda a, n: a.reshape(B, L, n, HEAD_DIM)
    fq = _rmsnorm(heads(fq, FOX_HEADS), fox_q_norm)
    fk = _rmsnorm(heads(fk, FOX_HEADS), fox_k_norm)
    log_f = jax.nn.log_sigmoid((f_logit + b_forget).astype(jnp.float32))
    log_f_cum = jnp.transpose(lax.cumsum(log_f, axis=1), (0, 2, 1))
    o_fox = _fox_attention(fq, fk, heads(fv, FOX_HEADS), log_f_cum).reshape(B, L, FOX_WIDTH)
    o_sb = _stick_breaking_attention(heads(sq, SB_HEADS), heads(sk, SB_HEADS),
                                     heads(sv, SB_HEADS)).reshape(B, L, SB_WIDTH)
    merged = jax.nn.sigmoid(g_fox) * (o_fox @ w_branch_fox) + jax.nn.sigmoid(g_sb) * (o_sb @ w_branch_sb)
    return merged @ w_out


def setup_inputs(seed: int = 0) -> dict:
    key = jax.random.key(seed)
    ks = jax.random.split(key, 20)
    f32 = jnp.float32
    nrm = lambda k, shape, fan_in: jax.random.normal(k, shape, f32) * (fan_in ** -0.5)
    gain = lambda k, shape: 1.0 + 0.02 * jax.random.normal(k, shape, f32)
    return {
        "x": jax.random.normal(ks[0], (BATCH, SEQ, D_MODEL), f32),
        "meta_tokens": jax.random.normal(ks[1], (N_META, D_MODEL), f32),
        "ffn1_norm": gain(ks[2], (DEPTH, D_MODEL)),
        "ffn1_w_gate": nrm(ks[3], (DEPTH, D_MODEL, D_FF), D_MODEL),
        "ffn1_w_up": nrm(ks[4], (DEPTH, D_MODEL, D_FF), D_MODEL),
        "ffn1_w_down": nrm(ks[5], (DEPTH, D_FF, D_MODEL), D_FF),
        "mix_norm": gain(ks[6], (DEPTH, D_MODEL)),
        "w_in": nrm(ks[7], (DEPTH, D_MODEL, IN_PROJ_WIDTH), D_MODEL),
        "b_forget": FORGET_BIAS_INIT + 0.1 * jax.random.normal(ks[8], (DEPTH, FOX_HEADS), f32),
        "fox_q_norm": gain(ks[9], (DEPTH, FOX_HEADS, HEAD_DIM)),
        "fox_k_norm": gain(ks[10], (DEPTH, FOX_HEADS, HEAD_DIM)),
        "w_branch_fox": nrm(ks[11], (DEPTH, FOX_WIDTH, D_MODEL), FOX_WIDTH),
        "w_branch_sb": nrm(ks[12], (DEPTH, SB_WIDTH, D_MODEL), SB_WIDTH),
        "w_out": nrm(ks[13], (DEPTH, D_MODEL, D_MODEL), D_MODEL),
        "ffn2_norm": gain(ks[14], (DEPTH, D_MODEL)),
        "ffn2_w_gate": nrm(ks[15], (DEPTH, D_MODEL, D_FF), D_MODEL),
        "ffn2_w_up": nrm(ks[16], (DEPTH, D_MODEL, D_FF), D_MODEL),
        "ffn2_w_down": nrm(ks[17], (DEPTH, D_FF, D_MODEL), D_FF),
    }


def reference(x, meta_tokens, ffn1_norm, ffn1_w_gate, ffn1_w_up, ffn1_w_down, mix_norm, w_in, b_forget,
              fox_q_norm, fox_k_norm, w_branch_fox, w_branch_sb, w_out, ffn2_norm, ffn2_w_gate, ffn2_w_up,
              ffn2_w_down):
    B = x.shape[0]
    meta = jnp.broadcast_to(meta_tokens[None].astype(x.dtype), (B, N_META, D_MODEL))
    h = jnp.concatenate([meta, x], axis=1)
    for layer in range(DEPTH):
        h = h + FFN_RESIDUAL_WEIGHT * _swiglu(_rmsnorm(h, ffn1_norm[layer]), ffn1_w_gate[layer],
                                              ffn1_w_up[layer], ffn1_w_down[layer])
        h = h + _hybrid_mixer(_rmsnorm(h, mix_norm[layer]), w_in[layer], b_forget[layer],
                              fox_q_norm[layer], fox_k_norm[layer], w_branch_fox[layer],
                              w_branch_sb[layer], w_out[layer])
        h = h + FFN_RESIDUAL_WEIGHT * _swiglu(_rmsnorm(h, ffn2_norm[layer]), ffn2_w_gate[layer],
                                              ffn2_w_up[layer], ffn2_w_down[layer])
    return h[:, N_META:]
```

```cpp
#include <hip/hip_runtime.h>
#include <hip/hip_cooperative_groups.h>
#include <cstdio>
#include <cstdint>
#include <cmath>
namespace cg = cooperative_groups;
namespace pg8 {
#define PG8_LAS __attribute__((address_space(3)))
typedef unsigned short bf16_t;
typedef short bf16x8 __attribute__((ext_vector_type(8)));
typedef float f32x4 __attribute__((ext_vector_type(4)));
typedef unsigned u32x4 __attribute__((ext_vector_type(4)));
constexpr int BM = 256, BK = 64, HALF = 128, HTB = HALF * BK * 2  , STAGE_BYTES = 8 * HTB, NXCD = 8, WGM = 8;

__host__ __device__ __forceinline__ int lds_byte(int r, int c) { const int st = (r >> 4) * 2 + (c >> 5), rr = r & 15, cc = c & 31, ob = rr * 64 + cc * 2; return st * 1024 + (ob ^ (((ob >> 9) & 1) << 5)); }
__host__ __device__ __forceinline__ void stage_rc(int b, int& R, int& C) { const int st = b / 1024, sb = b % 1024, swz = sb ^ (((sb >> 9) & 1) << 5); R = (st >> 1) * 16 + swz / 64; C = (st & 1) * 32 + (swz % 64) / 2; }
__host__ __device__ __forceinline__ int perm32(int rho) { const int n = rho >> 4, i = rho & 15; return 8 * (i >> 2) + 4 * n + (i & 3); }

struct Unit { int pm, pn, z, nt; };
struct Gemm { const bf16_t* A; const bf16_t* Bt; int M, N, K; size_t zA, zB; };

struct StaticOrder {
    int nM, nN, nwg, G, c;
    __host__ __device__ void init(int M, int N, int G_, int c_) { nM = M / BM; nN = N / BM; nwg = nM * nN; G = G_; c = c_; }
    __host__ __device__ bool next(int i, Unit& u) const {
        const long L = (long)i * G + c; if (L >= nwg) return false;
        int wgid = (int)L; { const int q = nwg / NXCD, r = nwg % NXCD, xcd = wgid % NXCD, off = wgid / NXCD; wgid = (xcd < r ? xcd * (q + 1) : r * (q + 1) + (xcd - r) * q) + off; }
        const int nig = WGM * nN, gid = wgid / nig, fm = gid * WGM, gsz = (nM - fm) < WGM ? (nM - fm) : WGM;
        u.pm = fm + ((wgid % nig) % gsz); u.pn = (wgid % nig) / gsz; u.z = 0; u.nt = 0; return true;
    }
    __device__ __forceinline__ void a_ready(const Unit&) const {}
    __device__ __forceinline__ void done(const Unit&) const {}
};


__device__ __forceinline__ unsigned cvt_pk_bf16(float lo, float hi) { unsigned r; asm volatile("s_nop 0\n\tv_cvt_pk_bf16_f32 %0, %1, %2" : "=v"(r) : "v"(lo), "v"(hi)); return r; }
template <class Epi, class Sched, bool ALIGN_EPI = false, bool SP2 = false>
__device__ __forceinline__ void gemm_phase(PG8_LAS unsigned char* lds, const Gemm g, const Sched& S, const Epi& E) {
    const int tid = threadIdx.x, wid = __builtin_amdgcn_readfirstlane(tid >> 6), lane = tid & 63, wr = wid >> 2, wc = wid & 3, fr = lane & 15, fq = lane >> 4;
    const int K = g.K, nt = K / BK;
    unsigned voffA[2], voffB[2];
#pragma unroll
    for (int i = 0; i < 2; ++i) { int R, C; stage_rc(tid * 16 + i * 8192, R, C); const int Rb = Epi::PERM ? ((R & ~31) + perm32(R & 31)) : R;
        voffA[i] = (unsigned)(R * K + C) * 2u; voffB[i] = (unsigned)(Rb * K + C) * 2u; }
    const size_t kstep = (size_t)(BK * 2);
    const size_t hstep = (size_t)HALF * K * 2;
    const size_t tstep = 2 * hstep;
    const unsigned ldsw = (unsigned)wid * 1024u;
    const int aoff = lds_byte(wr * 64 + fr, fq * 8), boff = lds_byte(wc * 32 + fr, fq * 8);
#define PG8_SA(b, h) (((b) * 2 + (h)) * HTB)
#define PG8_SB(b, h) ((4 + (b) * 2 + (h)) * HTB)
#define PG8_STAGE(bufoff, gbase, voff) do { _Pragma("unroll") for (int _i = 0; _i < 2; ++_i) \
        __builtin_amdgcn_global_load_lds((const unsigned*)((const char*)(gbase) + (voff)[_i]), (PG8_LAS unsigned*)(lds + (bufoff) + ldsw + _i * 8192), 16, 0, 0); } while (0)
#define PG8_LDA(dst, b, h) do { _Pragma("unroll") for (int m = 0; m < 4; ++m) _Pragma("unroll") for (int k = 0; k < 2; ++k) dst[m][k] = *(const PG8_LAS bf16x8*)(lds + PG8_SA(b, h) + aoff + m * 2048 + k * 1024); } while (0)
#define PG8_LDB(dst, b, h) do { _Pragma("unroll") for (int n = 0; n < 2; ++n) _Pragma("unroll") for (int k = 0; k < 2; ++k) dst[n][k] = *(const PG8_LAS bf16x8*)(lds + PG8_SB(b, h) + boff + n * 2048 + k * 1024); } while (0)
#define PG8_MMA(ai, bj, At, Bt) do { __builtin_amdgcn_s_setprio(1); _Pragma("unroll") for (int m = 0; m < 4; ++m) _Pragma("unroll") for (int n = 0; n < 2; ++n) _Pragma("unroll") for (int k = 0; k < 2; ++k) \
        acc[ai][bj][m][n] = __builtin_amdgcn_mfma_f32_16x16x32_bf16(Bt[n][k], At[m][k], acc[ai][bj][m][n], 0, 0, 0); __builtin_amdgcn_s_setprio(0); } while (0)
#define PG8_WAIT_V(n) asm volatile("s_waitcnt vmcnt(" #n ")" ::: "memory")
#define PG8_WAIT_L(n) asm volatile("s_waitcnt lgkmcnt(" #n ")" ::: "memory")
#define PG8_BAR __builtin_amdgcn_s_barrier()
#define PG8_SCHED __builtin_amdgcn_sched_barrier(0)
    Unit cur, nxt; int ui = 0;
    if (!S.next(0, cur)) return;
    f32x4 acc[2][2][4][2];
#pragma unroll
    for (int a = 0; a < 2; ++a)
#pragma unroll
        for (int b = 0; b < 2; ++b)
#pragma unroll
            for (int m = 0; m < 4; ++m)
#pragma unroll
                for (int n = 0; n < 2; ++n) acc[a][b][m][n] = (f32x4){0.f, 0.f, 0.f, 0.f};
    bf16x8 At[4][2], B0[2][2], B1[2][2];
    const char* cA = (const char*)g.A + (size_t)cur.pm * tstep + (size_t)cur.z * g.zA; const char* cB = (const char*)g.Bt + (size_t)cur.pn * tstep + (size_t)cur.z * g.zB;
    S.a_ready(cur);
    if constexpr (SP2) {
        PG8_STAGE(PG8_SB(0, 0), cB, voffB); PG8_STAGE(PG8_SB(0, 1), cB + hstep, voffB); PG8_STAGE(PG8_SA(0, 0), cA, voffA); PG8_STAGE(PG8_SA(0, 1), cA + hstep, voffA);
        if (wr == 1) PG8_BAR;
        PG8_WAIT_V(2); PG8_BAR;
        PG8_STAGE(PG8_SB(1, 0), cB + kstep, voffB); PG8_STAGE(PG8_SA(1, 0), cA + kstep, voffA); PG8_STAGE(PG8_SB(1, 1), cB + hstep + kstep, voffB);
        PG8_WAIT_V(6); PG8_BAR;
    } else {
        PG8_STAGE(PG8_SB(0, 0), cB, voffB); PG8_STAGE(PG8_SA(0, 0), cA, voffA); PG8_STAGE(PG8_SB(0, 1), cB + hstep, voffB); PG8_STAGE(PG8_SA(0, 1), cA + hstep, voffA);
        if (wr == 1) PG8_BAR;
        PG8_WAIT_V(4); PG8_BAR;
        PG8_STAGE(PG8_SB(1, 0), cB + kstep, voffB); PG8_STAGE(PG8_SA(1, 0), cA + kstep, voffA); PG8_STAGE(PG8_SB(1, 1), cB + hstep + kstep, voffB);
        PG8_WAIT_V(6); PG8_BAR;
    }
    for (;;) {
        const bool has_next = S.next(ui + 1, nxt);
        const char* nA = has_next ? (const char*)g.A + (size_t)nxt.pm * tstep + (size_t)nxt.z * g.zA : cA; const char* nB = has_next ? (const char*)g.Bt + (size_t)nxt.pn * tstep + (size_t)nxt.z * g.zB : cB;
        const int unt = cur.nt ? cur.nt : nt;
        for (int t = 0; t < unt; t += 2) {
            const bool last = (t == unt - 2);
            const char* a1 = cA + (size_t)(t + 1) * kstep;
            const char* a2 = last ? nA : cA + (size_t)(t + 2) * kstep; const char* b2 = last ? nB : cB + (size_t)(t + 2) * kstep;
            const char* a3 = a2 + kstep; const char* b3 = b2 + kstep;
            if (last && has_next) S.a_ready(nxt);
            if constexpr (SP2) {
            PG8_LDB(B0, 0, 0); PG8_LDB(B1, 0, 1); PG8_SCHED; PG8_LDA(At, 0, 0); PG8_STAGE(PG8_SA(1, 1), a1 + hstep, voffA);
            PG8_WAIT_V(8); PG8_WAIT_L(0); PG8_BAR; PG8_MMA(0, 0, At, B0); PG8_MMA(0, 1, At, B1); PG8_BAR; PG8_SCHED;
            PG8_LDA(At, 0, 1); PG8_STAGE(PG8_SB(0, 0), b2, voffB); PG8_STAGE(PG8_SB(0, 1), b2 + hstep, voffB); PG8_STAGE(PG8_SA(0, 0), a2, voffA);
            PG8_WAIT_V(8); PG8_WAIT_L(0); PG8_BAR; PG8_MMA(1, 0, At, B0); PG8_MMA(1, 1, At, B1); PG8_BAR; PG8_SCHED;
            PG8_LDB(B0, 1, 0); PG8_LDB(B1, 1, 1); PG8_SCHED; PG8_LDA(At, 1, 0); PG8_STAGE(PG8_SA(0, 1), a2 + hstep, voffA);
            PG8_WAIT_V(8); PG8_WAIT_L(0); PG8_BAR; PG8_MMA(0, 0, At, B0); PG8_MMA(0, 1, At, B1); PG8_BAR; PG8_SCHED;
            PG8_LDA(At, 1, 1); PG8_STAGE(PG8_SB(1, 0), b3, voffB); PG8_STAGE(PG8_SB(1, 1), b3 + hstep, voffB); PG8_STAGE(PG8_SA(1, 0), a3, voffA);
            PG8_WAIT_V(8); PG8_WAIT_L(0); PG8_BAR; PG8_MMA(1, 0, At, B0); PG8_MMA(1, 1, At, B1); PG8_BAR; PG8_SCHED;
            } else {
            PG8_LDB(B0, 0, 0); PG8_SCHED; PG8_LDA(At, 0, 0); PG8_STAGE(PG8_SA(1, 1), a1 + hstep, voffA);
            PG8_WAIT_L(8); PG8_BAR; PG8_WAIT_L(0); PG8_MMA(0, 0, At, B0); PG8_BAR; PG8_SCHED;
            PG8_LDB(B1, 0, 1); PG8_STAGE(PG8_SB(0, 0), b2, voffB);
            PG8_BAR; PG8_WAIT_L(0); PG8_MMA(0, 1, At, B1); PG8_BAR;
            PG8_LDA(At, 0, 1); PG8_STAGE(PG8_SA(0, 0), a2, voffA);
            PG8_BAR; PG8_WAIT_L(0); PG8_MMA(1, 0, At, B0); PG8_BAR; PG8_SCHED;
            PG8_STAGE(PG8_SB(0, 1), b2 + hstep, voffB);
            PG8_WAIT_V(6); PG8_BAR; PG8_MMA(1, 1, At, B1); PG8_BAR;
            PG8_LDB(B0, 1, 0); PG8_SCHED; PG8_LDA(At, 1, 0); PG8_STAGE(PG8_SA(0, 1), a2 + hstep, voffA);
            PG8_WAIT_L(8); PG8_BAR; PG8_WAIT_L(0); PG8_MMA(0, 0, At, B0); PG8_BAR; PG8_SCHED;
            PG8_LDB(B1, 1, 1); PG8_STAGE(PG8_SB(1, 0), b3, voffB);
            PG8_BAR; PG8_WAIT_L(0); PG8_MMA(0, 1, At, B1); PG8_BAR;
            PG8_LDA(At, 1, 1); PG8_STAGE(PG8_SA(1, 0), a3, voffA);
            PG8_BAR; PG8_WAIT_L(0); PG8_MMA(1, 0, At, B0); PG8_BAR; PG8_SCHED;
            PG8_STAGE(PG8_SB(1, 1), b3 + hstep, voffB);
            PG8_WAIT_V(6); PG8_BAR; PG8_MMA(1, 1, At, B1); PG8_BAR;
            }
        }
        if constexpr (ALIGN_EPI) { if (wr == 0) PG8_BAR; }
        if constexpr (!Epi::AFTER_DRAIN) { E(acc, cur, wr, wc, fr, fq); S.done(cur); }
        if (!has_next) break;
#pragma unroll
        for (int a = 0; a < 2; ++a)
#pragma unroll
            for (int b = 0; b < 2; ++b)
#pragma unroll
                for (int m = 0; m < 4; ++m)
#pragma unroll
                    for (int n = 0; n < 2; ++n) acc[a][b][m][n] = (f32x4){0.f, 0.f, 0.f, 0.f};
        cur = nxt; cA = nA; cB = nB; ++ui;
        if constexpr (ALIGN_EPI) { if (wr == 1) PG8_BAR; }
    }
    PG8_WAIT_V(0);
    if constexpr (!ALIGN_EPI) { if (wr == 0) PG8_BAR; }
    PG8_BAR;
    if constexpr (Epi::AFTER_DRAIN) { E.fused(acc, cur, wr, wc, fr, fq, lds, wid, lane); S.done(cur); }
#undef PG8_SA
#undef PG8_SB
#undef PG8_STAGE
#undef PG8_LDA
#undef PG8_LDB
#undef PG8_MMA
#undef PG8_WAIT_V
#undef PG8_WAIT_L
#undef PG8_BAR
#undef PG8_SCHED
}
}

constexpr int DM = 2048, FF = 5632, SEQ = 4096, NB = 2, NMETA = 16, HD = 128, NH = 8, HW = 1024;
constexpr int MREAL = NB * SEQ;
constexpr int MALL = MREAL + NMETA;
constexpr int MPAD = 8448;
constexpr int LSEQ = 4160;
constexpr int LLOG = NMETA + SEQ;
constexpr int NIN = 10240;
constexpr int WIN_LD = 10248;
constexpr float RMS_EPS = 1e-6f;
constexpr float LOG2E = 1.4426950408889634f;
constexpr int NPHASE = 12;
#ifndef MK_N_LAUNCHES
#define MK_N_LAUNCHES 1
#endif

constexpr size_t MiB = 1u << 20;
constexpr size_t WS_WGU1 = 1 * MiB, WS_WD1 = 45 * MiB, WS_WGU2 = 67 * MiB, WS_WD2 = 111 * MiB, WS_WIN = 133 * MiB, WS_WBF = 173 * MiB, WS_WBS = 177 * MiB, WS_WOUT = 181 * MiB;
constexpr size_t WS_XN = 189 * MiB;
constexpr size_t WS_U = 222 * MiB;
constexpr size_t WS_G = WS_U;
constexpr size_t WS_Q = 313 * MiB;
constexpr size_t WS_MRG = WS_Q;
constexpr size_t WS_K = 345 * MiB;
constexpr size_t WS_VT = 379 * MiB;
constexpr size_t WS_O = WS_XN;
constexpr size_t WS_MISC = 413 * MiB;
constexpr size_t WS_END = 415 * MiB;
constexpr size_t KV_STRIDE = 17 * MiB;
constexpr size_t MISC_LOGF = 128 * 1024, MISC_C2 = 512 * 1024, MISC_KVM = 1024 * 1024;

constexpr int LDS_BYTES = 147456;

#define GAS __attribute__((address_space(1)))
#define LAS __attribute__((address_space(3)))
typedef unsigned short bf16;
typedef unsigned v4u __attribute__((ext_vector_type(4)));
typedef unsigned v2u __attribute__((ext_vector_type(2)));
typedef float f32x4 __attribute__((ext_vector_type(4)));
typedef short bf16x8 __attribute__((ext_vector_type(8)));
#define LDS_WAIT() asm volatile("s_waitcnt lgkmcnt(0)" ::: "memory")

__device__ __forceinline__ unsigned pk2(float lo, float hi) { return pg8::cvt_pk_bf16(lo, hi); }
__device__ __forceinline__ float bf_lo(unsigned w) { return __uint_as_float(w << 16); }
__device__ __forceinline__ float bf_hi(unsigned w) { return __uint_as_float(w & 0xffff0000u); }
__device__ __forceinline__ float wave_sum(float v) {
#pragma unroll
    for (int o = 1; o < 64; o <<= 1) v += __shfl_xor(v, o);
    return v;
}
__device__ __forceinline__ float fast_sigmoid(float v) { return __builtin_amdgcn_rcpf(1.0f + __builtin_amdgcn_exp2f(-v * LOG2E)); }
__device__ __forceinline__ float log_sigmoid_acc(float x) { return fminf(x, 0.f) - log1pf(expf(-fabsf(x))); }

__device__ __forceinline__ void tr_item(const float* W, int ldw, int K, int n_src, bf16* WT, int drow, LAS float* scr, int k0, int lane) {
    const int kr = lane >> 4, nc = lane & 15;
    f32x4 v[16];
#pragma unroll
    for (int i = 0; i < 16; ++i) v[i] = *(const f32x4*)(W + (size_t)(k0 + 4 * i + kr) * ldw + n_src + 4 * nc);
#pragma unroll
    for (int i = 0; i < 16; ++i) { LAS float* d = scr + (4 * i + kr) * 65 + 4 * nc; d[0] = v[i].x; d[1] = v[i].y; d[2] = v[i].z; d[3] = v[i].w; }
    LDS_WAIT(); asm volatile("" ::: "memory");
    const int c = lane & 7;
#pragma unroll
    for (int j = 0; j < 8; ++j) { const int n = (lane >> 3) + 8 * j; const LAS float* s = scr + (8 * c) * 65 + n;
        v4u o; o.x = pk2(s[0 * 65], s[1 * 65]); o.y = pk2(s[2 * 65], s[3 * 65]); o.z = pk2(s[4 * 65], s[5 * 65]); o.w = pk2(s[6 * 65], s[7 * 65]);
        *(v4u*)(WT + (size_t)(drow + n) * K + k0 + 8 * c) = o; }
    LDS_WAIT(); asm volatile("" ::: "memory");
}
__device__ __forceinline__ void tr_seg(const float* W, int ldw, int K, int ncols, int n_src0, bf16* WT, int mode, int drow0, int r, LAS float* scr, int lane) {
    const int nblk = ncols >> 6, kb = r / nblk, nb = r - kb * nblk, n0 = nb * 64;
    const int drow = mode == 0 ? drow0 + n0 : ((n0 >> 7) << 8) + (n0 & 127) + (mode == 2 ? 128 : 0);
    tr_item(W, ldw, K, n_src0 + n0, WT, drow, scr, kb * 64, lane);
}
__device__ __forceinline__ void rms_row(const float* src, const float* add, float alpha, const float* gain, bf16* dst, int lane, f32x4 (&v)[8]) {
    float ss = 0.f;
#pragma unroll
    for (int j = 0; j < 8; ++j) { v[j] = ((const f32x4*)src)[lane + 64 * j]; if (add) v[j] = v[j] + ((const f32x4*)add)[lane + 64 * j] * alpha; ss += (v[j].x * v[j].x + v[j].y * v[j].y) + (v[j].z * v[j].z + v[j].w * v[j].w); }
    const float rstd = 1.0f / sqrtf(wave_sum(ss) * (1.0f / DM) + RMS_EPS);
#pragma unroll
    for (int j = 0; j < 8; ++j) { const f32x4 g = ((const f32x4*)gain)[lane + 64 * j]; v[j] = v[j] * rstd * g;
        v2u o; o.x = pk2(v[j].x, v[j].y); o.y = pk2(v[j].z, v[j].w); ((v2u*)dst)[lane + 64 * j] = o; }
}

struct EpiSwiglu {
    static constexpr bool PERM = true, AFTER_DRAIN = false; bf16* U;
    __device__ __forceinline__ void operator()(const f32x4 (&acc)[2][2][4][2], const pg8::Unit& u, int wr, int wc, int fr, int fq) const {
        const int row0 = u.pm * 256 + wr * 64 + fr, col = u.pn * 128 + wc * 32 + 8 * fq;
#pragma unroll
        for (int ai = 0; ai < 2; ++ai)
#pragma unroll
            for (int m = 0; m < 4; ++m) {
                const f32x4 g0 = acc[ai][0][m][0], g1 = acc[ai][0][m][1], u0 = acc[ai][1][m][0], u1 = acc[ai][1][m][1];
                f32x4 r0, r1;
#pragma unroll
                for (int e = 0; e < 4; ++e) { r0[e] = g0[e] * fast_sigmoid(g0[e]) * u0[e]; r1[e] = g1[e] * fast_sigmoid(g1[e]) * u1[e]; }
                v4u w; w.x = pk2(r0[0], r0[1]); w.y = pk2(r0[2], r0[3]); w.z = pk2(r1[0], r1[1]); w.w = pk2(r1[2], r1[3]);
                *(v4u*)(U + (size_t)(row0 + ai * 128 + m * 16) * FF + col) = w; }
    }
};
struct EpiResid {
    static constexpr bool PERM = false, AFTER_DRAIN = false;
    const float* base_real; const float* base_meta; float* out_real; float* out_meta; float alpha; int mvalid;
    __device__ __forceinline__ void operator()(const f32x4 (&acc)[2][2][4][2], const pg8::Unit& u, int wr, int wc, int fr, int fq) const {
        const int col0 = u.pn * 256 + wc * 32 + 4 * fq;
#pragma unroll
        for (int ai = 0; ai < 2; ++ai)
#pragma unroll
            for (int m = 0; m < 4; ++m) {
                const int row = u.pm * 256 + ai * 128 + wr * 64 + m * 16 + fr;
                if (row >= mvalid) continue;
                if (row >= MREAL) {
                    float* op = out_meta + (size_t)(row - MREAL) * DM;
#pragma unroll
                    for (int bj = 0; bj < 2; ++bj)
#pragma unroll
                        for (int n = 0; n < 2; ++n) { const int c = col0 + bj * 128 + n * 16;
#pragma unroll
                            for (int e = 0; e < 4; ++e) atomicAdd(op + c + e, acc[ai][bj][m][n][e]); }
                    continue; }
                const float* bp = row < MREAL ? base_real + (size_t)row * DM : base_meta + (size_t)(row - MREAL) * DM;
                float* op = row < MREAL ? out_real + (size_t)row * DM : out_meta + (size_t)(row - MREAL) * DM;
#pragma unroll
                for (int bj = 0; bj < 2; ++bj)
#pragma unroll
                    for (int n = 0; n < 2; ++n) { const int c = col0 + bj * 128 + n * 16; const f32x4 bs = *(const f32x4*)(bp + c); *(f32x4*)(op + c) = bs + acc[ai][bj][m][n] * alpha; }
            }
    }
};
struct EpiInproj {
    static constexpr bool PERM = true, AFTER_DRAIN = false;
    bf16* Q; bf16* K; bf16* VT; bf16* G; float* KVM;
    __device__ __forceinline__ void operator()(const f32x4 (&acc)[2][2][4][2], const pg8::Unit& u, int wr, int wc, int fr, int fq) const {
        const int pn = u.pn;
        const int which = (pn >= 12 && pn < 24) ? 1 : 0;
        const int kind = pn >= 24 ? 3 : ((pn - which * 12) >> 2);
        const int ct = kind == 3 ? (pn - 24) : ((pn - which * 12) & 3);
        if (u.pm == 32) {
            if (wr == 0) {
                const int cbase = (which * 2 + (kind - 1)) * 1024 + ct * 256 + wc * 32 + 8 * fq;
#pragma unroll
                for (int bj = 0; bj < 2; ++bj)
#pragma unroll
                    for (int n = 0; n < 2; ++n)
#pragma unroll
                        for (int e = 0; e < 4; ++e) atomicAdd(KVM + (size_t)fr * 4096 + cbase + bj * 128 + 4 * n + e, acc[0][bj][0][n][e]);
            }
            return;
        }
#pragma unroll
        for (int ai = 0; ai < 2; ++ai)
#pragma unroll
            for (int m = 0; m < 4; ++m) {
                const int row = u.pm * 256 + ai * 128 + wr * 64 + m * 16 + fr;
                if (row >= MALL) continue;
                const bool meta = row >= MREAL;
                const int b = row >> 12, t = row & 4095, mi = row - MREAL;
#pragma unroll
                for (int bj = 0; bj < 2; ++bj) {
                    const int col = ct * 256 + bj * 128 + wc * 32 + 8 * fq;
                    const f32x4 v0 = acc[ai][bj][m][0], v1 = acc[ai][bj][m][1];
                    if (kind == 3) {
                        if (!meta) { v4u w; w.x = pk2(fast_sigmoid(v0[0]), fast_sigmoid(v0[1])); w.y = pk2(fast_sigmoid(v0[2]), fast_sigmoid(v0[3]));
                            w.z = pk2(fast_sigmoid(v1[0]), fast_sigmoid(v1[1])); w.w = pk2(fast_sigmoid(v1[2]), fast_sigmoid(v1[3]));
                            *(v4u*)(G + (size_t)row * 4096 + col) = w; }
                    } else if (kind == 0) {
                        if (!meta) { v4u w; w.x = pk2(v0[0], v0[1]); w.y = pk2(v0[2], v0[3]); w.z = pk2(v1[0], v1[1]); w.w = pk2(v1[2], v1[3]);
                            *(v4u*)(Q + (size_t)which * ((size_t)MREAL * HW) + (size_t)row * HW + col) = w; }
                    } else if (kind == 1) {
                        v4u w; w.x = pk2(v0[0], v0[1]); w.y = pk2(v0[2], v0[3]); w.z = pk2(v1[0], v1[1]); w.w = pk2(v1[2], v1[3]);
                        bf16* kb = K + (size_t)which * (KV_STRIDE / 2);
                        if (!meta) *(v4u*)(kb + (size_t)(b * LSEQ + 64 + t) * HW + col) = w;
                        else { *(v4u*)(kb + (size_t)mi * HW + col) = w; *(v4u*)(kb + (size_t)(LSEQ + mi) * HW + col) = w; }
                    } else {
                        bf16* vb = VT + (size_t)which * (KV_STRIDE / 2);
                        const int h = col >> 7, d0 = col & 127;
#pragma unroll
                        for (int e = 0; e < 8; ++e) {
                            const float val = e < 4 ? v0[e & 3] : v1[e & 3];
                            const bf16 hv = (bf16)(pk2(val, 0.f) & 0xffffu);
                            if (!meta) vb[(size_t)((b * NH + h) * HD + d0 + e) * LSEQ + 64 + t] = hv;
                            else { vb[(size_t)((0 * NH + h) * HD + d0 + e) * LSEQ + mi] = hv; vb[(size_t)((1 * NH + h) * HD + d0 + e) * LSEQ + mi] = hv; }
                        }
                    }
                }
            }
    }
};
struct EpiBranch {
    static constexpr bool PERM = true, AFTER_DRAIN = false;
    const bf16* G; bf16* MRG;
    __device__ __forceinline__ void operator()(const f32x4 (&acc)[2][2][4][2], const pg8::Unit& u, int wr, int wc, int fr, int fq) const {
#pragma unroll
        for (int ai = 0; ai < 2; ++ai)
#pragma unroll
            for (int m = 0; m < 4; ++m) {
                const int row = u.pm * 256 + ai * 128 + wr * 64 + m * 16 + fr;
#pragma unroll
                for (int bj = 0; bj < 2; ++bj) {
                    const int col = u.pn * 256 + bj * 128 + wc * 32 + 8 * fq;
                    const v4u g = *(const v4u*)(G + (size_t)row * 4096 + u.z * 2048 + col);
                    bf16* mp = MRG + (size_t)row * DM + col;
                    v4u pv = (v4u){0u, 0u, 0u, 0u}; if (u.z) pv = *(const v4u*)mp;
                    const f32x4 v0 = acc[ai][bj][m][0], v1 = acc[ai][bj][m][1];
                    v4u w;
                    w.x = pk2(bf_lo(pv.x) + bf_lo(g.x) * v0[0], bf_hi(pv.x) + bf_hi(g.x) * v0[1]);
                    w.y = pk2(bf_lo(pv.y) + bf_lo(g.y) * v0[2], bf_hi(pv.y) + bf_hi(g.y) * v0[3]);
                    w.z = pk2(bf_lo(pv.z) + bf_lo(g.z) * v1[0], bf_hi(pv.z) + bf_hi(g.z) * v1[1]);
                    w.w = pk2(bf_lo(pv.w) + bf_lo(g.w) * v1[2], bf_hi(pv.w) + bf_hi(g.w) * v1[3]);
                    *(v4u*)mp = w;
                }
            }
    }
};

struct InprojOrder {
    pg8::StaticOrder S;
    __device__ __forceinline__ bool next(int i, pg8::Unit& u) const {
        const long L = (long)i * S.G + S.c;
        if (L < S.nwg) return S.next(i, u);
        const int e = (int)(L - S.nwg); if (e >= 128) return false;
        const int ct = e & 15; u.pm = 32; u.pn = ct < 8 ? 4 + ct : 8 + ct; u.z = e >> 4; u.nt = 4; return true;
    }
    __device__ __forceinline__ void a_ready(const pg8::Unit&) const {}
    __device__ __forceinline__ void done(const pg8::Unit&) const {}
};
struct DownOrder {
    pg8::StaticOrder S;
    __device__ __forceinline__ bool next(int i, pg8::Unit& u) const {
        const long L = (long)i * S.G + S.c;
        if (L < S.nwg) return S.next(i, u);
        const int e = (int)(L - S.nwg); if (e >= 176) return false;
        u.pm = 32; u.pn = e & 7; u.z = e >> 3; u.nt = 4; return true;
    }
    __device__ __forceinline__ void a_ready(const pg8::Unit&) const {}
    __device__ __forceinline__ void done(const pg8::Unit&) const {}
};
template <class Sch, int REPN> struct RepOrder {
    Sch S; int nc;
    __device__ __forceinline__ void count() { pg8::Unit u; nc = 0; while (S.next(nc, u)) ++nc; }
    __device__ __forceinline__ bool next(int i, pg8::Unit& u) const { if (nc == 0 || i >= REPN * nc) return false; return S.next(i % nc, u); }
    __device__ __forceinline__ void a_ready(const pg8::Unit&) const {}
    __device__ __forceinline__ void done(const pg8::Unit&) const {}
};
struct MetaTailOrder {
    pg8::StaticOrder S;
    __device__ __forceinline__ bool next(int i, pg8::Unit& u) const {
        const long L = (long)i * S.G + S.c;
        if (L < S.nwg) return S.next(i, u);
        const int e = (int)(L - S.nwg); if (e >= 2 * FF / 256) return false;
        u.pm = 32; u.pn = e; u.z = 0; u.nt = 0; return true;
    }
    __device__ __forceinline__ void a_ready(const pg8::Unit&) const {}
    __device__ __forceinline__ void done(const pg8::Unit&) const {}
};
struct BranchOrder {
    pg8::StaticOrder S;
    __device__ __forceinline__ bool next(int i, pg8::Unit& u) const { if (!S.next(i >> 1, u)) return false; u.z = i & 1; return true; }
    __device__ __forceinline__ void a_ready(const pg8::Unit&) const {}
    __device__ __forceinline__ void done(const pg8::Unit&) const {}
};

template <int TYPE>
__device__ __forceinline__ void attn_unit(LAS unsigned char* lds, const bf16* Qb, const bf16* Kb, const bf16* VTb, const float* c2, bf16* Ob, int b, int h, int qb, int tid, int wave, int lane) {
    const int fr = lane & 15, fq = lane >> 4;
    LAS unsigned char* ldsK = lds; LAS unsigned char* ldsV = lds + 17408; volatile LAS int* flags = (volatile LAS int*)(lds + 36864);
    const int t0 = qb * 128, tq = t0 + wave * 16 + fr, qpos = 64 + tq;
    const int qmin = 64 + t0 + wave * 16, qmax = qmin + 15;
    const bf16* qrow = Qb + (size_t)(b * SEQ + tq) * HW + h * HD + fq * 8;
    bf16x8 qf[4];
#pragma unroll
    for (int kk = 0; kk < 4; ++kk) qf[kk] = *(const bf16x8*)(qrow + 32 * kk);
    f32x4 o[8];
#pragma unroll
    for (int n = 0; n < 8; ++n) o[n] = (f32x4){0.f, 0.f, 0.f, 0.f};
    float m_run = -INFINITY, l_run = 0.f, R = 0.f;
    const float* c2row = c2 + (size_t)(b * NH + h) * LSEQ;
    float cq = 0.f; if (TYPE == 0) cq = c2row[qpos];
    const unsigned char* Kg = (const unsigned char*)(Kb + (size_t)(b * LSEQ) * HW + h * HD) + (size_t)(tid >> 4) * 2048 + (tid & 15) * 16;
    const unsigned char* Vg = (const unsigned char*)(VTb + (size_t)((b * NH + h) * HD) * LSEQ) + (size_t)(tid >> 3) * (LSEQ * 2) + (tid & 7) * 16;
    const int ldsKw = (tid >> 4) * 272 + (tid & 15) * 16, ldsVw = (tid >> 3) * 144 + (tid & 7) * 16;
    v4u kr0, kr1, vr0, vr1;
    const int kt_last = 2 * qb + 2;
#define A_LOADG(kt_) do { const unsigned char* kp_ = Kg + (size_t)(kt_) * (64 * 2048); kr0 = *(const v4u*)kp_; kr1 = *(const v4u*)(kp_ + 32 * 2048); \
        const unsigned char* vp_ = Vg + (size_t)(kt_) * 128; vr0 = *(const v4u*)vp_; vr1 = *(const v4u*)(vp_ + 64 * (LSEQ * 2)); } while (0)
    f32x4 ckn[4];
#define C_LOADG(kt_) do { if (TYPE == 0) { _Pragma("unroll") for (int j_ = 0; j_ < 4; ++j_) ckn[j_] = *(const f32x4*)(c2row + 64 * (kt_) + 16 * j_ + 4 * fq); } } while (0)
    C_LOADG(kt_last); A_LOADG(kt_last);
    for (int kt = kt_last; kt >= 0; --kt) {
        *(LAS v4u*)(ldsK + ldsKw) = kr0; *(LAS v4u*)(ldsK + ldsKw + 32 * 272) = kr1;
        *(LAS v4u*)(ldsV + ldsVw) = vr0; *(LAS v4u*)(ldsV + ldsVw + 64 * 144) = vr1;
        f32x4 ck[4];
        if (TYPE == 0) {
#pragma unroll
            for (int j = 0; j < 4; ++j) ck[j] = ckn[j];
        }
        __syncthreads();
        if (kt > 0) { C_LOADG(kt - 1); A_LOADG(kt - 1); }
        const int kbase = 64 * kt;
        const bool skip = TYPE == 0 ? (kbase > qmax) : ((kbase >= qmax) || __all(R < -104.0f));
        if (!skip) {
            f32x4 s[4];
#pragma unroll
            for (int j = 0; j < 4; ++j) { s[j] = (f32x4){0.f, 0.f, 0.f, 0.f}; if (TYPE == 0) s[j] = cq - ck[j];
#pragma unroll
                for (int kk = 0; kk < 4; ++kk) { const bf16x8 kf = *(const LAS bf16x8*)(ldsK + (16 * j + fr) * 272 + kk * 64 + fq * 16);
                    s[j] = __builtin_amdgcn_mfma_f32_16x16x32_bf16(kf, qf[kk], s[j], 0, 0, 0); } }
            const bool need_mask = (kt == 0) || (kbase + 63 >= qmin);
            if (TYPE == 0) {
                if (need_mask) {
                    asm volatile("; masked tile");
#pragma unroll
                    for (int j = 0; j < 4; ++j)
#pragma unroll
                        for (int i = 0; i < 4; ++i) { const int kp = kbase + 16 * j + 4 * fq + i; const bool valid = (kp <= qpos) && (kt > 0 || kp < NMETA); s[j][i] = valid ? s[j][i] : -INFINITY; }
                }
                float mx = -INFINITY;
#pragma unroll
                for (int j = 0; j < 4; ++j) mx = fmaxf(mx, fmaxf(fmaxf(s[j][0], s[j][1]), fmaxf(s[j][2], s[j][3])));
                mx = fmaxf(mx, __shfl_xor(mx, 16)); mx = fmaxf(mx, __shfl_xor(mx, 32));
                const float mnew = fmaxf(m_run, mx), alpha = __builtin_amdgcn_exp2f(m_run - mnew); m_run = mnew;
                float ps = 0.f;
#pragma unroll
                for (int j = 0; j < 4; ++j)
#pragma unroll
                    for (int i = 0; i < 4; ++i) { const float p = __builtin_amdgcn_exp2f(s[j][i] - mnew); ps += p; s[j][i] = p; }
                l_run = l_run * alpha + ps;
                if (__any(alpha != 1.0f)) {
#pragma unroll
                    for (int n = 0; n < 8; ++n) o[n] = o[n] * alpha;
                }
            } else {
                const float SC = 0.08838834764831845f;
                float T[4], hi[4], TT[4];
                f32x4 lbv[4];
#pragma unroll
                for (int j = 0; j < 4; ++j) { float tj = 0.f;
#pragma unroll
                    for (int i = 0; i < 4; ++i) { const float z = s[j][i] * SC; const float e = __expf(-fabsf(z)); const float sp = fmaxf(z, 0.f) + __logf(1.0f + e);
                        bool valid = true; if (need_mask) { const int kp = kbase + 16 * j + 4 * fq + i; valid = (kp < qpos) && (kt > 0 || kp < NMETA); }
                        const float lom = valid ? -sp : 0.f; lbv[j][i] = valid ? (z - sp) : -INFINITY; s[j][i] = lom; tj += lom; }
                    T[j] = tj; }
#pragma unroll
                for (int j = 0; j < 4; ++j) { const float a1 = __shfl_xor(T[j], 16), a2 = __shfl_xor(T[j], 32), a3 = __shfl_xor(T[j], 48);
                    hi[j] = fq == 0 ? (a1 + a2 + a3) : (fq == 1 ? (a2 + a3) : (fq == 2 ? a1 : 0.f)); TT[j] = T[j] + a1 + a2 + a3; }
                float run = R;
#pragma unroll
                for (int j = 3; j >= 0; --j) { float tt = run + hi[j];
                    const float w3 = __expf(lbv[j][3] + tt); tt += s[j][3];
                    const float w2 = __expf(lbv[j][2] + tt); tt += s[j][2];
                    const float w1 = __expf(lbv[j][1] + tt); tt += s[j][1];
                    const float w0 = __expf(lbv[j][0] + tt);
                    s[j] = (f32x4){w0, w1, w2, w3}; run += TT[j]; }
                R = run;
            }
            bf16x8 pb[2];
#pragma unroll
            for (int k2 = 0; k2 < 2; ++k2) { v4u w; w.x = pk2(s[2 * k2][0], s[2 * k2][1]); w.y = pk2(s[2 * k2][2], s[2 * k2][3]);
                w.z = pk2(s[2 * k2 + 1][0], s[2 * k2 + 1][1]); w.w = pk2(s[2 * k2 + 1][2], s[2 * k2 + 1][3]); pb[k2] = __builtin_bit_cast(bf16x8, w); }
#pragma unroll
            for (int n = 0; n < 8; ++n)
#pragma unroll
                for (int k2 = 0; k2 < 2; ++k2) { const LAS unsigned char* vp = ldsV + (16 * n + fr) * 144 + k2 * 64 + fq * 8;
                    const v2u a = *(const LAS v2u*)vp, c = *(const LAS v2u*)(vp + 32); const v4u vv = (v4u){a.x, a.y, c.x, c.y};
                    o[n] = __builtin_amdgcn_mfma_f32_16x16x32_bf16(__builtin_bit_cast(bf16x8, vv), pb[k2], o[n], 0, 0, 0); }
        }
        if (TYPE == 1) { const int dn = __all(R < -104.0f) ? 1 : 0; if (lane == 0) flags[wave] = dn; }
        __syncthreads();
        if (TYPE == 1) { const int f = lane < 8 ? flags[lane] : 1; if (__all(f != 0)) break; }
    }
#undef A_LOADG
#undef C_LOADG
    if (TYPE == 0) { float l = l_run + __shfl_xor(l_run, 16); l += __shfl_xor(l, 32); const float inv = 1.0f / l;
#pragma unroll
        for (int n = 0; n < 8; ++n) o[n] = o[n] * inv; }
    bf16* orow = Ob + (size_t)(b * SEQ + tq) * HW + h * HD + 4 * fq;
#pragma unroll
    for (int n = 0; n < 8; ++n) { v2u w; w.x = pk2(o[n][0], o[n][1]); w.y = pk2(o[n][2], o[n][3]); *(v2u*)(orow + 16 * n) = w; }
}


__device__ __forceinline__ void fox_sp_unit(LAS unsigned char* lds, const bf16* Qb, const bf16* Kb, const bf16* VTb, const float* c2, bf16* Ob, int b, int h, int qb, int tid, int wave, int lane) {
    constexpr int KB = 17664, V0 = 2 * KB, VB = 18432;
    const int fr = lane & 15, fq = lane >> 4;
    const int t0 = qb * 128, tq = t0 + wave * 16 + fr, qpos = 64 + tq;
    const int qmin = 64 + t0 + wave * 16, qmax = qmin + 15;
    const bf16* qrow = Qb + (size_t)(b * SEQ + tq) * HW + h * HD + fq * 8;
    bf16x8 qf[4];
#pragma unroll
    for (int kk = 0; kk < 4; ++kk) qf[kk] = *(const bf16x8*)(qrow + 32 * kk);
    f32x4 o[8];
#pragma unroll
    for (int n = 0; n < 8; ++n) o[n] = (f32x4){0.f, 0.f, 0.f, 0.f};
    float m_run = -INFINITY, l_run = 0.f;
    const float* c2row = c2 + (size_t)(b * NH + h) * LSEQ;
    const float cq = c2row[qpos];
    const unsigned char* Kg = (const unsigned char*)(Kb + (size_t)(b * LSEQ) * HW + h * HD) + (size_t)(tid >> 4) * 2048 + (tid & 15) * 16;
    const unsigned char* Vg = (const unsigned char*)(VTb + (size_t)((b * NH + h) * HD) * LSEQ) + (size_t)(tid >> 3) * (LSEQ * 2) + (tid & 7) * 16;
    const int ldsKw = (tid >> 4) * 272 + (tid & 15) * 16, ldsVw = (tid >> 3) * 144 + (tid & 7) * 16;
    v4u kr0, kr1, vr0, vr1; f32x4 cr;
#define SP_LOADK(kt_) do { cr = *(const f32x4*)(c2row + 64 * (kt_) + 4 * (tid & 15)); const unsigned char* kp_ = Kg + (size_t)(kt_) * (64 * 2048); kr0 = *(const v4u*)kp_; kr1 = *(const v4u*)(kp_ + 32 * 2048); } while (0)
#define SP_LOADV(kt_) do { const unsigned char* vp_ = Vg + (size_t)(kt_) * 128; vr0 = *(const v4u*)vp_; vr1 = *(const v4u*)(vp_ + 64 * (LSEQ * 2)); } while (0)
#define SP_STOREK(kt_) do { LAS unsigned char* w_ = lds + ((kt_) & 1) * KB; *(LAS v4u*)(w_ + ldsKw) = kr0; *(LAS v4u*)(w_ + ldsKw + 32 * 272) = kr1; if (tid < 16) *(LAS f32x4*)(w_ + 17408 + tid * 16) = cr; } while (0)
#define SP_STOREV(kt_) do { LAS unsigned char* w_ = lds + V0 + ((kt_) & 1) * VB; *(LAS v4u*)(w_ + ldsVw) = vr0; *(LAS v4u*)(w_ + ldsVw + 64 * 144) = vr1; } while (0)
#define SP_QK(dst, bi_) do { const LAS unsigned char* kb_ = lds + (bi_) * KB; _Pragma("unroll") for (int j = 0; j < 4; ++j) { const f32x4 ck_ = *(const LAS f32x4*)(kb_ + 17408 + (16 * j + 4 * fq) * 4); dst[j] = cq - ck_; \
        _Pragma("unroll") for (int kk = 0; kk < 4; ++kk) { const bf16x8 kf_ = *(const LAS bf16x8*)(kb_ + (16 * j + fr) * 272 + kk * 64 + fq * 16); dst[j] = __builtin_amdgcn_mfma_f32_16x16x32_bf16(kf_, qf[kk], dst[j], 0, 0, 0); } } } while (0)
    const int T = 2 * qb + 2;
    SP_LOADK(T); SP_LOADV(T); SP_STOREK(T); SP_STOREV(T);
    SP_LOADK(T - 1); SP_STOREK(T - 1);
    SP_LOADK(T - 2); SP_LOADV(T - 1);
    __syncthreads();
    f32x4 s_cur[4];
    SP_QK(s_cur, T & 1);
    __syncthreads();
    for (int t = T; t >= 0; --t) {
        if (t >= 1) SP_STOREV(t - 1);
        if (t >= 2) SP_STOREK(t - 2);
        if (t >= 2) SP_LOADV(t - 2);
        if (t >= 3) SP_LOADK(t - 3);
        const int kbase = 64 * t;
        f32x4 s_nxt[4];
        SP_QK(s_nxt, (t + 1) & 1);
        asm volatile("" ::: "memory");
        if (kbase <= qmax) {
            if ((t == 0) || (kbase + 63 >= qmin)) {
                asm volatile("; masked tile");
#pragma unroll
                for (int j = 0; j < 4; ++j)
#pragma unroll
                    for (int i = 0; i < 4; ++i) { const int kp = kbase + 16 * j + 4 * fq + i; const bool valid = (kp <= qpos) && (t > 0 || kp < NMETA); s_cur[j][i] = valid ? s_cur[j][i] : -INFINITY; }
            }
            float mx = -INFINITY;
#pragma unroll
            for (int j = 0; j < 4; ++j) mx = fmaxf(mx, fmaxf(fmaxf(s_cur[j][0], s_cur[j][1]), fmaxf(s_cur[j][2], s_cur[j][3])));
            mx = fmaxf(mx, __shfl_xor(mx, 16)); mx = fmaxf(mx, __shfl_xor(mx, 32));
            const float mnew = fmaxf(m_run, mx), alpha = __builtin_amdgcn_exp2f(m_run - mnew); m_run = mnew;
            float ps = 0.f;
#pragma unroll
            for (int j = 0; j < 4; ++j)
#pragma unroll
                for (int i = 0; i < 4; ++i) { const float p = __builtin_amdgcn_exp2f(s_cur[j][i] - mnew); ps += p; s_cur[j][i] = p; }
            l_run = l_run * alpha + ps;
            if (__any(alpha != 1.0f)) {
#pragma unroll
                for (int n = 0; n < 8; ++n) o[n] = o[n] * alpha;
            }
            bf16x8 pb[2];
#pragma unroll
            for (int k2 = 0; k2 < 2; ++k2) { v4u w; w.x = pk2(s_cur[2 * k2][0], s_cur[2 * k2][1]); w.y = pk2(s_cur[2 * k2][2], s_cur[2 * k2][3]);
                w.z = pk2(s_cur[2 * k2 + 1][0], s_cur[2 * k2 + 1][1]); w.w = pk2(s_cur[2 * k2 + 1][2], s_cur[2 * k2 + 1][3]); pb[k2] = __builtin_bit_cast(bf16x8, w); }
            const LAS unsigned char* vb = lds + V0 + (t & 1) * VB;
#pragma unroll
            for (int n = 0; n < 8; ++n)
#pragma unroll
                for (int k2 = 0; k2 < 2; ++k2) { const LAS unsigned char* vp = vb + (16 * n + fr) * 144 + k2 * 64 + fq * 8;
                    const v2u a = *(const LAS v2u*)vp, c = *(const LAS v2u*)(vp + 32); const v4u vv = (v4u){a.x, a.y, c.x, c.y};
                    o[n] = __builtin_amdgcn_mfma_f32_16x16x32_bf16(__builtin_bit_cast(bf16x8, vv), pb[k2], o[n], 0, 0, 0); }
        }
        __syncthreads();
#pragma unroll
        for (int j = 0; j < 4; ++j) s_cur[j] = s_nxt[j];
    }
#undef SP_LOADK
#undef SP_LOADV
#undef SP_STOREK
#undef SP_STOREV
#undef SP_QK
    float l = l_run + __shfl_xor(l_run, 16); l += __shfl_xor(l, 32); const float inv = 1.0f / l;
    bf16* orow = Ob + (size_t)(b * SEQ + tq) * HW + h * HD + 4 * fq;
#pragma unroll
    for (int n = 0; n < 8; ++n) { const f32x4 r = o[n] * inv; v2u w; w.x = pk2(r[0], r[1]); w.y = pk2(r[2], r[3]); *(v2u*)(orow + 16 * n) = w; }
}


__device__ __forceinline__ void fox_sp32_unit(LAS unsigned char* lds, const bf16* Qb, const bf16* Kb, const bf16* VTb, const float* c2, bf16* Ob, int b, int h, int qb, int tid, int wave, int lane) {
    constexpr int KB = 17664, V0 = 2 * KB, VB = 18432, MRG = 73728;
    const int fr = lane & 15, fq = lane >> 4, rg = wave & 3, kh = wave >> 2;
    LAS f32x4* mrg = (LAS f32x4*)(lds + MRG);
    const int t0 = qb * 128, tq0 = t0 + rg * 32 + fr;
    const int qmin = 64 + t0 + rg * 32, qmax = qmin + 31;
    bf16x8 qf[2][4];
#pragma unroll
    for (int q2 = 0; q2 < 2; ++q2) { const bf16* qrow = Qb + (size_t)(b * SEQ + tq0 + 16 * q2) * HW + h * HD + fq * 8;
#pragma unroll
        for (int kk = 0; kk < 4; ++kk) qf[q2][kk] = *(const bf16x8*)(qrow + 32 * kk); }
    f32x4 o[2][8];
#pragma unroll
    for (int q2 = 0; q2 < 2; ++q2)
#pragma unroll
        for (int n = 0; n < 8; ++n) o[q2][n] = (f32x4){0.f, 0.f, 0.f, 0.f};
    float m_run[2] = {-INFINITY, -INFINITY}, l_run[2] = {0.f, 0.f};
    const float* c2row = c2 + (size_t)(b * NH + h) * LSEQ;
    float cq[2]; cq[0] = c2row[64 + tq0]; cq[1] = c2row[64 + tq0 + 16];
    const unsigned char* Kg = (const unsigned char*)(Kb + (size_t)(b * LSEQ) * HW + h * HD) + (size_t)(tid >> 4) * 2048 + (tid & 15) * 16;
    const unsigned char* Vg = (const unsigned char*)(VTb + (size_t)((b * NH + h) * HD) * LSEQ) + (size_t)(tid >> 3) * (LSEQ * 2) + (tid & 7) * 16;
    const int ldsKw = (tid >> 4) * 272 + (tid & 15) * 16, ldsVw = (tid >> 3) * 144 + (tid & 7) * 16;
    v4u kr0, kr1, vr0, vr1; f32x4 cr;
#define SP_LOADK(kt_) do { cr = *(const f32x4*)(c2row + 64 * (kt_) + 4 * (tid & 15)); const unsigned char* kp_ = Kg + (size_t)(kt_) * (64 * 2048); kr0 = *(const v4u*)kp_; kr1 = *(const v4u*)(kp_ + 32 * 2048); } while (0)
#define SP_LOADV(kt_) do { const unsigned char* vp_ = Vg + (size_t)(kt_) * 128; vr0 = *(const v4u*)vp_; vr1 = *(const v4u*)(vp_ + 64 * (LSEQ * 2)); } while (0)
#define SP_STOREK(kt_) do { LAS unsigned char* w_ = lds + ((kt_) & 1) * KB; *(LAS v4u*)(w_ + ldsKw) = kr0; *(LAS v4u*)(w_ + ldsKw + 32 * 272) = kr1; if (tid < 16) *(LAS f32x4*)(w_ + 17408 + tid * 16) = cr; } while (0)
#define SP_STOREV(kt_) do { LAS unsigned char* w_ = lds + V0 + ((kt_) & 1) * VB; *(LAS v4u*)(w_ + ldsVw) = vr0; *(LAS v4u*)(w_ + ldsVw + 64 * 144) = vr1; } while (0)
#define SP_QK(dst, bi_) do { const LAS unsigned char* kb_ = lds + (bi_) * KB; _Pragma("unroll") for (int jb = 0; jb < 2; ++jb) { const f32x4 ck_ = *(const LAS f32x4*)(kb_ + 17408 + (32 * kh + 16 * jb + 4 * fq) * 4); dst[jb][0] = cq[0] - ck_; dst[jb][1] = cq[1] - ck_; \
        _Pragma("unroll") for (int kk = 0; kk < 4; ++kk) { const bf16x8 kf_ = *(const LAS bf16x8*)(kb_ + (32 * kh + 16 * jb + fr) * 272 + kk * 64 + fq * 16); \
            dst[jb][0] = __builtin_amdgcn_mfma_f32_16x16x32_bf16(kf_, qf[0][kk], dst[jb][0], 0, 0, 0); dst[jb][1] = __builtin_amdgcn_mfma_f32_16x16x32_bf16(kf_, qf[1][kk], dst[jb][1], 0, 0, 0); } } } while (0)
    const int T = 2 * qb + 2;
    SP_LOADK(T); SP_LOADV(T); SP_STOREK(T); SP_STOREV(T);
    SP_LOADK(T - 1); SP_STOREK(T - 1);
    SP_LOADK(T - 2); SP_LOADV(T - 1);
    __syncthreads();
    f32x4 s_cur[2][2];
    SP_QK(s_cur, T & 1);
    __syncthreads();
    for (int t = T; t >= 0; --t) {
        if (t >= 1) SP_STOREV(t - 1);
        if (t >= 2) SP_STOREK(t - 2);
        if (t >= 2) SP_LOADV(t - 2);
        if (t >= 3) SP_LOADK(t - 3);
        const int kb0 = 64 * t + 32 * kh;
        f32x4 s_nxt[2][2];
        SP_QK(s_nxt, (t + 1) & 1);
        asm volatile("" ::: "memory");
        if (!((kb0 > qmax) || (t == 0 && kh == 1))) {
            if ((t == 0) || (kb0 + 31 > qmin)) {
                asm volatile("; masked tile");
#pragma unroll
                for (int q2 = 0; q2 < 2; ++q2)
#pragma unroll
                    for (int jb = 0; jb < 2; ++jb)
#pragma unroll
                        for (int i = 0; i < 4; ++i) { const int kp = kb0 + 16 * jb + 4 * fq + i; const bool valid = (kp <= qmin + 16 * q2 + fr) && (t > 0 || kp < NMETA); s_cur[jb][q2][i] = valid ? s_cur[jb][q2][i] : -INFINITY; }
            }
            float alpha[2];
#pragma unroll
            for (int q2 = 0; q2 < 2; ++q2) {
                float mx = fmaxf(fmaxf(fmaxf(s_cur[0][q2][0], s_cur[0][q2][1]), fmaxf(s_cur[0][q2][2], s_cur[0][q2][3])), fmaxf(fmaxf(s_cur[1][q2][0], s_cur[1][q2][1]), fmaxf(s_cur[1][q2][2], s_cur[1][q2][3])));
                mx = fmaxf(mx, __shfl_xor(mx, 16)); mx = fmaxf(mx, __shfl_xor(mx, 32));
                const float mnew = fmaxf(m_run[q2], mx); alpha[q2] = __builtin_amdgcn_exp2f(m_run[q2] - mnew); m_run[q2] = mnew;
                float ps = 0.f;
#pragma unroll
                for (int jb = 0; jb < 2; ++jb)
#pragma unroll
                    for (int i = 0; i < 4; ++i) { const float p = __builtin_amdgcn_exp2f(s_cur[jb][q2][i] - mnew); ps += p; s_cur[jb][q2][i] = p; }
                l_run[q2] = l_run[q2] * alpha[q2] + ps;
            }
            if (__any((alpha[0] != 1.0f) || (alpha[1] != 1.0f))) {
#pragma unroll
                for (int n = 0; n < 8; ++n) { o[0][n] = o[0][n] * alpha[0]; o[1][n] = o[1][n] * alpha[1]; }
            }
            bf16x8 pb[2];
#pragma unroll
            for (int q2 = 0; q2 < 2; ++q2) { v4u w; w.x = pk2(s_cur[0][q2][0], s_cur[0][q2][1]); w.y = pk2(s_cur[0][q2][2], s_cur[0][q2][3]);
                w.z = pk2(s_cur[1][q2][0], s_cur[1][q2][1]); w.w = pk2(s_cur[1][q2][2], s_cur[1][q2][3]); pb[q2] = __builtin_bit_cast(bf16x8, w); }
            const LAS unsigned char* vb = lds + V0 + (t & 1) * VB;
#pragma unroll
            for (int n = 0; n < 8; ++n) { const LAS unsigned char* vp = vb + (16 * n + fr) * 144 + kh * 64 + fq * 8;
                const v2u a = *(const LAS v2u*)vp, c = *(const LAS v2u*)(vp + 32); const v4u vv = (v4u){a.x, a.y, c.x, c.y}; const bf16x8 vf = __builtin_bit_cast(bf16x8, vv);
                o[0][n] = __builtin_amdgcn_mfma_f32_16x16x32_bf16(vf, pb[0], o[0][n], 0, 0, 0);
                o[1][n] = __builtin_amdgcn_mfma_f32_16x16x32_bf16(vf, pb[1], o[1][n], 0, 0, 0); }
        }
        __syncthreads();
#pragma unroll
        for (int jb = 0; jb < 2; ++jb) { s_cur[jb][0] = s_nxt[jb][0]; s_cur[jb][1] = s_nxt[jb][1]; }
    }
#undef SP_LOADK
#undef SP_LOADV
#undef SP_STOREK
#undef SP_STOREV
#undef SP_QK
    if (kh == 1) {
#pragma unroll
        for (int q2 = 0; q2 < 2; ++q2)
#pragma unroll
            for (int n = 0; n < 8; ++n) mrg[(rg * 17 + q2 * 8 + n) * 64 + lane] = o[q2][n];
        mrg[(rg * 17 + 16) * 64 + lane] = (f32x4){m_run[0], m_run[1], l_run[0], l_run[1]};
    }
    __syncthreads();
    if (kh == 0) {
        const f32x4 st = mrg[(rg * 17 + 16) * 64 + lane];
#pragma unroll
        for (int q2 = 0; q2 < 2; ++q2) {
            const float m1 = q2 ? st.y : st.x, l1 = q2 ? st.w : st.z;
            const float m = fmaxf(m_run[q2], m1), e0 = __builtin_amdgcn_exp2f(m_run[q2] - m), e1 = __builtin_amdgcn_exp2f(m1 - m);
            float l = l_run[q2] * e0 + l1 * e1; l += __shfl_xor(l, 16); l += __shfl_xor(l, 32);
            const float inv = 1.0f / l, w0 = e0 * inv, w1 = e1 * inv;
            bf16* orow = Ob + (size_t)(b * SEQ + tq0 + 16 * q2) * HW + h * HD + 4 * fq;
#pragma unroll
            for (int n = 0; n < 8; ++n) { const f32x4 o1 = mrg[(rg * 17 + q2 * 8 + n) * 64 + lane]; const f32x4 r = o[q2][n] * w0 + o1 * w1;
                v2u w; w.x = pk2(r[0], r[1]); w.y = pk2(r[2], r[3]); *(v2u*)(orow + 16 * n) = w; }
        }
    }
    __syncthreads();
}

#define XB_TMO      128
#define XB_XCNT(j)  (256  + 64 * (j))
#define XB_XSUB(j)  (1280 + 64 * (j))
#define XB_XGEN(j)  (2304 + 64 * (j))
#define XB_TOP      3328
#define XB_TOPGEN   3392
#define XCD_BAR_WORDS 3456
#define XB_SPIN_CAP (1u << 18)

__device__ __forceinline__ unsigned xb_ld(unsigned* p)              { return __hip_atomic_load(p, __ATOMIC_RELAXED, __HIP_MEMORY_SCOPE_AGENT); }
__device__ __forceinline__ unsigned xb_add(unsigned* p, unsigned v) { return __hip_atomic_fetch_add(p, v, __ATOMIC_RELAXED, __HIP_MEMORY_SCOPE_AGENT); }
__device__ __forceinline__ unsigned xb_xcc_id() { return (unsigned)__builtin_amdgcn_s_getreg((3 << 11) | 20) & 0xFu; }
#define XB_SPIN(cond, bar) do { unsigned _sp = 0; while (cond) { __builtin_amdgcn_s_sleep(1); \
    if ((++_sp & 255u) == 0u) { if (xb_ld(&(bar)[XB_TMO])) break; if (_sp > XB_SPIN_CAP) { atomicAdd(&(bar)[XB_TMO], 1u); break; } } } } while (0)

struct XcdBarrier {
    unsigned* bar; unsigned x;
    volatile LAS unsigned* st;
};

__device__ __forceinline__ XcdBarrier xcd_barrier_post(unsigned* bar, volatile LAS unsigned* st) {
    XcdBarrier b; b.bar = bar; b.x = xb_xcc_id(); b.st = st;
    if (threadIdx.x == 0) (void)xb_add(&bar[XB_XCNT(b.x)], 1u);
    return b;
}
__device__ __forceinline__ void xcd_barrier_complete(unsigned* bar, unsigned x, unsigned& nloc, unsigned& nx) {
    const unsigned G = gridDim.x * gridDim.y * gridDim.z;
    unsigned sum, cnt, mine, sp = 0u;
    for (;;) {
        sum = 0u; cnt = 0u; mine = 0u;
#pragma unroll
        for (unsigned j = 0; j < 16; ++j) { const unsigned c = xb_ld(&bar[XB_XCNT(j)]); sum += c; cnt += (c > 0u) ? 1u : 0u; mine = (j == x) ? c : mine; }
        if (sum == G) break;
        __builtin_amdgcn_s_sleep(1);
        if ((++sp & 255u) == 0u) { if (xb_ld(&bar[XB_TMO])) break; if (sp > XB_SPIN_CAP) { atomicAdd(&bar[XB_TMO], 1u); break; } }
    }
    nloc = mine > 0u ? mine : 1u; nx = cnt > 0u ? cnt : 1u;
}

__device__ __forceinline__ void xcd_barrier(const XcdBarrier& b) {
    asm volatile("s_waitcnt vmcnt(0)" ::: "memory");
    __syncthreads();
    if (threadIdx.x == 0) {
        unsigned* bar = b.bar;
        __builtin_amdgcn_s_waitcnt(0);
        unsigned nloc = b.st[0], nx = b.st[1];
        if (nloc == 0u) { xcd_barrier_complete(bar, b.x, nloc, nx); b.st[0] = nloc; b.st[1] = nx; }
        const unsigned old = xb_add(&bar[XB_XSUB(b.x)], 1u);
        const unsigned gen = old / nloc;
        if (old + 1u == (gen + 1u) * nloc) {
            __builtin_amdgcn_fence(__ATOMIC_RELEASE, "agent");
            asm volatile("s_waitcnt vmcnt(0)" ::: "memory");
            const unsigned og = xb_add(&bar[XB_TOP], 1u);
            const unsigned tg = og / nx;
            if (og + 1u == (tg + 1u) * nx) xb_add(&bar[XB_TOPGEN], 1u);
            else XB_SPIN(xb_ld(&bar[XB_TOPGEN]) == tg, bar);
            __builtin_amdgcn_fence(__ATOMIC_ACQUIRE, "agent");
            xb_add(&bar[XB_XGEN(b.x)], 1u);
            asm volatile("s_waitcnt vmcnt(0)" ::: "memory");
        } else {
            XB_SPIN(xb_ld(&bar[XB_XGEN(b.x)]) == gen, bar);
            __builtin_amdgcn_fence(__ATOMIC_ACQUIRE, "agent");
            asm volatile("s_waitcnt vmcnt(0)" ::: "memory");
        }
    }
    __syncthreads();
}

struct Args { const float* in[18]; float* out; unsigned char* ws; int ph_lo, ph_hi; };

__global__ void __launch_bounds__(512, 2) mk_fwd(Args a) {
    extern __shared__ __attribute__((aligned(16))) unsigned char lds_raw[];
    LAS unsigned char* lds = (LAS unsigned char*)lds_raw;
    const int tid = threadIdx.x, lane = tid & 63, wave = __builtin_amdgcn_readfirstlane(tid >> 6);
    const int G = gridDim.x, bx = blockIdx.x;
    const int vcu = (G % 8 == 0) ? (bx % 8) * (G / 8) + bx / 8 : bx;
    const int gw = vcu * 8 + wave, NGW = G * 8;
    unsigned char* ws = a.ws;
    const float* x = a.in[0]; const float* meta = a.in[1];
    float* out = a.out;
    bf16* Wgu1 = (bf16*)(ws + WS_WGU1); bf16* Wd1 = (bf16*)(ws + WS_WD1); bf16* Wgu2 = (bf16*)(ws + WS_WGU2); bf16* Wd2 = (bf16*)(ws + WS_WD2);
    bf16* Win = (bf16*)(ws + WS_WIN); bf16* Wbf = (bf16*)(ws + WS_WBF); bf16* Wbs = (bf16*)(ws + WS_WBS); bf16* Wout = (bf16*)(ws + WS_WOUT);
    bf16* XN = (bf16*)(ws + WS_XN); bf16* U = (bf16*)(ws + WS_U); bf16* Gt = (bf16*)(ws + WS_G); bf16* Qb = (bf16*)(ws + WS_Q); bf16* MRG = (bf16*)(ws + WS_MRG);
    bf16* Kb = (bf16*)(ws + WS_K); bf16* VTb = (bf16*)(ws + WS_VT); bf16* Ob = (bf16*)(ws + WS_O);
    float* H1M = (float*)(ws + WS_MISC); float* LOGF = (float*)(ws + WS_MISC + MISC_LOGF); float* C2 = (float*)(ws + WS_MISC + MISC_C2); float* KVM = (float*)(ws + WS_MISC + MISC_KVM);
    const int lo = a.ph_lo, hi = a.ph_hi;
    volatile LAS unsigned* bst = (volatile LAS unsigned*)(lds + LDS_BYTES - 64);
    if (tid < 16) bst[tid] = 0u;
    __syncthreads();
    XcdBarrier xbar = xcd_barrier_post((unsigned*)ws, bst);
    if (lo < 0) cg::this_grid().sync();
#define IN(k) (lo <= (k) && (k) < hi)
#ifndef REP_PH
#define REP_PH -1
#define REP_N 1
#endif
#define REPS(k) for (int rep_ = 0; rep_ < ((k) == REP_PH ? REP_N : 1); ++rep_)
#define SEAM(k) do { if (IN(k) && IN((k) + 1)) xcd_barrier(xbar); } while (0)

    if (IN(0)) REPS(0) {
        LAS float* scr = (LAS float*)(lds + wave * 16640);
        constexpr int I_GU = (DM / 64) * (FF / 64), I_D = (FF / 64) * (DM / 64), I_IN1 = (DM / 64) * (3072 / 64), I_IN2 = (DM / 64) * (7168 / 64), I_BR = (HW / 64) * (DM / 64), I_OUT = (DM / 64) * (DM / 64);
        constexpr int NITEMS = 2 * I_GU;
        for (int it = gw; it < NITEMS; it += NGW) {
            int r = it;
            if (r < I_GU) { tr_seg(a.in[3], FF, DM, FF, 0, Wgu1, 1, 0, r, scr, lane); continue; } r -= I_GU;
            tr_seg(a.in[4], FF, DM, FF, 0, Wgu1, 2, 0, r - 0, scr, lane);
        }
        for (int r = gw; r < MALL; r += NGW) { f32x4 v[8]; const float* src = r < MREAL ? x + (size_t)r * DM : meta + (size_t)(r - MREAL) * DM; rms_row(src, nullptr, 0.f, a.in[2], XN + (size_t)r * DM, lane, v); }
        const int gt = vcu * 512 + tid, NGT = G * 512;
        for (int i = gt; i < NMETA * 4096 / 4; i += NGT) ((f32x4*)KVM)[i] = (f32x4){0.f, 0.f, 0.f, 0.f};
        for (int i = gt; i < NMETA * DM / 4; i += NGT) ((f32x4*)H1M)[i] = (f32x4){0.f, 0.f, 0.f, 0.f};
        for (int i = gt; i < (MPAD - MALL) * DM / 8; i += NGT) ((v4u*)(XN + (size_t)MALL * DM))[i] = (v4u){0u, 0u, 0u, 0u};
        for (int i = gt; i < 4 * 48 * 128; i += NGT) { const int wb = i / (48 * 128), rem = i - wb * (48 * 128);
            *(v4u*)((unsigned char*)Kb + (size_t)(wb >> 1) * KV_STRIDE + ((size_t)((wb & 1) * LSEQ + 16) * HW) * 2 + (size_t)rem * 16) = (v4u){0u, 0u, 0u, 0u}; }
        for (int i = gt; i < 2 * NB * NH * HD * 6; i += NGT) { const int rr = i / 6, c = i - rr * 6; const int wh = rr / (NB * NH * HD), row = rr - wh * (NB * NH * HD);
            *(v4u*)((unsigned char*)VTb + (size_t)wh * KV_STRIDE + ((size_t)row * LSEQ + 16) * 2 + (size_t)c * 16) = (v4u){0u, 0u, 0u, 0u}; }
    }
    SEAM(0);
    if (IN(1)) REPS(1) {
        pg8::Gemm g{XN, Wgu1, MPAD, 2 * FF, DM, 0, 0}; MetaTailOrder S; S.S.init(MREAL, 2 * FF, G, bx);
        EpiSwiglu E{U};
        pg8::gemm_phase<EpiSwiglu, MetaTailOrder, true, true>(lds, g, S, E);
        {
            const int rem = (S.S.nwg + 2 * FF / 256) % G;
            if (rem != 0 && bx >= rem) {
                LAS float* scr = (LAS float*)(lds + wave * 16640);
                constexpr int I_GU = (DM / 64) * (FF / 64);
                constexpr int I_D = (FF / 64) * (DM / 64);
                for (int r = (bx - rem) * 8 + wave; r < I_D + I_GU; r += (G - rem) * 8) {
                    if (r < I_D) tr_seg(a.in[5], DM, FF, DM, 0, Wd1, 0, 0, r, scr, lane); else tr_seg(a.in[15], FF, DM, FF, 0, Wgu2, 1, 0, r - I_D, scr, lane); }
            } else if (rem == 0) {
                LAS float* scr = (LAS float*)(lds + wave * 16640);
                constexpr int I_GU = (DM / 64) * (FF / 64);
                constexpr int I_D = (FF / 64) * (DM / 64);
                for (int r = gw; r < I_D + I_GU; r += NGW) {
                    if (r < I_D) tr_seg(a.in[5], DM, FF, DM, 0, Wd1, 0, 0, r, scr, lane); else tr_seg(a.in[15], FF, DM, FF, 0, Wgu2, 1, 0, r - I_D, scr, lane); }
            }
        }
    }
    SEAM(1);
    if (IN(2)) REPS(2) {
        pg8::Gemm g{U, Wd1, MPAD, DM, FF, 256 * 2, 256 * 2}; DownOrder S; S.S.init(MREAL, DM, G, bx);
        EpiResid E{x, meta, out, H1M, 0.5f, MALL};
        pg8::gemm_phase<EpiResid, DownOrder, true, true>(lds, g, S, E);
        {
            const int rem = (S.S.nwg + 176) % G; constexpr int I_IN1 = (DM / 64) * (3072 / 64);
            LAS float* scr = (LAS float*)(lds + wave * 16640);
            if (rem != 0 && bx >= rem) { for (int r = (bx - rem) * 8 + wave; r < I_IN1; r += (G - rem) * 8) tr_seg(a.in[7], WIN_LD, DM, 3072, 0, Win, 0, 0, r, scr, lane); }
            else if (rem == 0) { for (int r = gw; r < I_IN1; r += NGW) tr_seg(a.in[7], WIN_LD, DM, 3072, 0, Win, 0, 0, r, scr, lane); }
        }
    }
    SEAM(2);
    if (IN(3)) REPS(3) {
        LAS float* wf = (LAS float*)lds;
        for (int i = tid; i < 8 * DM; i += 512) { const int k = i >> 3, j = i & 7; wf[j * DM + k] = a.in[7][(size_t)k * WIN_LD + 3072 + j]; }
        __syncthreads();
        for (int r = gw; r < MALL; r += NGW) {
            f32x4 v[8]; const float* src = r < MREAL ? out + (size_t)r * DM : meta + (size_t)(r - MREAL) * DM;
            rms_row(src, r < MREAL ? nullptr : H1M + (size_t)(r - MREAL) * DM, 0.5f, a.in[6], XN + (size_t)r * DM, lane, v);
            float mine = 0.f;
#pragma unroll
            for (int j = 0; j < 8; ++j) { float p = 0.f;
#pragma unroll
                for (int jj = 0; jj < 8; ++jj) { const f32x4 w = *(const LAS f32x4*)(wf + j * DM + 256 * jj + 4 * lane); p += (v[jj].x * w.x + v[jj].y * w.y) + (v[jj].z * w.z + v[jj].w * w.w); }
                p = wave_sum(p); mine = (lane == j) ? p : mine; }
            if (lane < 8) { const float lf = log_sigmoid_acc(mine + a.in[8][lane]);
                if (r < MREAL) LOGF[((size_t)(r >> 12) * LLOG + NMETA + (r & 4095)) * NH + lane] = lf;
                else { LOGF[((size_t)0 * LLOG + (r - MREAL)) * NH + lane] = lf; LOGF[((size_t)1 * LLOG + (r - MREAL)) * NH + lane] = lf; } }
        }
        __syncthreads();
        {
            constexpr int I_IN2 = (DM / 64) * (7168 / 64); LAS float* scr = (LAS float*)(lds + wave * 16640);
            for (int r = gw; r < I_IN2; r += NGW) tr_seg(a.in[7], WIN_LD, DM, 7168, 3080, Win, 0, 3072, r, scr, lane);
        }
    }
    SEAM(3);
    if (IN(4)) REPS(4) {
        pg8::Gemm g{XN, Win, MPAD, NIN, DM, 256 * 2, 256 * 2}; InprojOrder S; S.S.init(MREAL, NIN, G, bx);
        EpiInproj E{Qb, Kb, VTb, Gt, KVM};
        pg8::gemm_phase<EpiInproj, InprojOrder, true, true>(lds, g, S, E);
        {
            const int rem = (S.S.nwg + 128) % G; constexpr int I_BR = (HW / 64) * (DM / 64), I_OUT = (DM / 64) * (DM / 64);
            LAS float* scr = (LAS float*)(lds + wave * 16640);
            const bool idle = rem != 0 && bx >= rem;
            if (idle || rem == 0) {
                const int r0 = idle ? (bx - rem) * 8 + wave : gw, rs = idle ? (G - rem) * 8 : NGW;
                for (int r = r0; r < 2 * I_BR + I_OUT; r += rs) {
                    if (r < I_BR) tr_seg(a.in[11], DM, HW, DM, 0, Wbf, 0, 0, r, scr, lane);
                    else if (r < 2 * I_BR) tr_seg(a.in[12], DM, HW, DM, 0, Wbs, 0, 0, r - I_BR, scr, lane);
                    else tr_seg(a.in[13], DM, DM, DM, 0, Wout, 0, 0, r - 2 * I_BR, scr, lane); }
            }
        }
    }
    SEAM(4);
    if (IN(5)) REPS(5) {
        for (int r = gw; r < MREAL + NB * LSEQ; r += NGW) {
            bf16* p; const float* gn;
            if (r < MREAL) { p = Qb + (size_t)r * HW; gn = a.in[9]; }
            else { const int kr = r - MREAL, pos = kr >= LSEQ ? kr - LSEQ : kr; if (pos < 64) continue; p = Kb + (size_t)kr * HW; gn = a.in[10]; }
            const v4u w0 = ((const v4u*)p)[2 * lane], w1 = ((const v4u*)p)[2 * lane + 1];
            float f[16];
            f[0] = bf_lo(w0.x); f[1] = bf_hi(w0.x); f[2] = bf_lo(w0.y); f[3] = bf_hi(w0.y); f[4] = bf_lo(w0.z); f[5] = bf_hi(w0.z); f[6] = bf_lo(w0.w); f[7] = bf_hi(w0.w);
            f[8] = bf_lo(w1.x); f[9] = bf_hi(w1.x); f[10] = bf_lo(w1.y); f[11] = bf_hi(w1.y); f[12] = bf_lo(w1.z); f[13] = bf_hi(w1.z); f[14] = bf_lo(w1.w); f[15] = bf_hi(w1.w);
            float ss = 0.f;
#pragma unroll
            for (int e = 0; e < 16; ++e) ss += f[e] * f[e];
            ss += __shfl_xor(ss, 1); ss += __shfl_xor(ss, 2); ss += __shfl_xor(ss, 4);
            const float rstd = (1.0f / sqrtf(ss * (1.0f / HD) + RMS_EPS)) * (r < MREAL ? 0.08838834764831845f * LOG2E : 1.0f);
#pragma unroll
            for (int e4 = 0; e4 < 4; ++e4) { const f32x4 g4 = ((const f32x4*)gn)[4 * lane + e4];
                f[4 * e4 + 0] *= rstd * g4.x; f[4 * e4 + 1] *= rstd * g4.y; f[4 * e4 + 2] *= rstd * g4.z; f[4 * e4 + 3] *= rstd * g4.w; }
            v4u o0, o1; o0.x = pk2(f[0], f[1]); o0.y = pk2(f[2], f[3]); o0.z = pk2(f[4], f[5]); o0.w = pk2(f[6], f[7]);
            o1.x = pk2(f[8], f[9]); o1.y = pk2(f[10], f[11]); o1.z = pk2(f[12], f[13]); o1.w = pk2(f[14], f[15]);
            ((v4u*)p)[2 * lane] = o0; ((v4u*)p)[2 * lane + 1] = o1;
        }
        for (int it = NGW - 1 - gw; it < NMETA * 4 * NH; it += NGW) {
            const int i = it >> 5, j = (it >> 3) & 3, hh = it & 7, wh = j >> 1;
            const float* src = KVM + (size_t)i * 4096 + j * 1024 + hh * HD + 2 * lane; float v0 = src[0], v1 = src[1];
            if (j == 0) { const float ss = wave_sum(v0 * v0 + v1 * v1); const float rstd = 1.0f / sqrtf(ss * (1.0f / HD) + RMS_EPS); v0 *= rstd * a.in[10][hh * HD + 2 * lane]; v1 *= rstd * a.in[10][hh * HD + 2 * lane + 1]; }
            const unsigned pk = pk2(v0, v1);
            if ((j & 1) == 0) { bf16* kb = Kb + (size_t)wh * (KV_STRIDE / 2); *(unsigned*)(kb + (size_t)i * HW + hh * HD + 2 * lane) = pk; *(unsigned*)(kb + (size_t)(LSEQ + i) * HW + hh * HD + 2 * lane) = pk; }
            else { bf16* vb = VTb + (size_t)wh * (KV_STRIDE / 2);
#pragma unroll
                for (int bb = 0; bb < NB; ++bb) { vb[(size_t)((bb * NH + hh) * HD + 2 * lane) * LSEQ + i] = (bf16)(pk & 0xffffu); vb[(size_t)((bb * NH + hh) * HD + 2 * lane + 1) * LSEQ + i] = (bf16)(pk >> 16); } }
        }
        if (gw < NB * NH) {
            const int b = gw >> 3, h = gw & 7; const float* lf = LOGF + (size_t)b * LLOG * NH + h; float* cr = C2 + (size_t)(b * NH + h) * LSEQ;
            const int l0 = lane * 65; float s = 0.f; float xv[65];
#pragma unroll
            for (int i = 0; i < 65; ++i) { const int li = l0 + i; xv[i] = li < LLOG ? lf[(size_t)li * NH] : 0.f; }
#pragma unroll
            for (int i = 0; i < 65; ++i) s += xv[i];
            float inc = s;
#pragma unroll
            for (int o = 1; o < 64; o <<= 1) { const float t = __shfl_up(inc, o); if (lane >= o) inc += t; }
            float run = inc - s;
#pragma unroll
            for (int i = 0; i < 65; ++i) { const int li = l0 + i; run += xv[i]; if (li < LLOG) cr[li < NMETA ? li : li + 48] = run * LOG2E; }
        }
    }
    SEAM(5);
    if (IN(6)) REPS(6) {
        for (int it = vcu; it < 512; it += G) {
            const int type = it >> 8, p = it & 255, bh = p >> 4, xx = p & 15, b = bh >> 3, h = bh & 7;
            for (int half = 0; half < 2; ++half) { const int qb = half ? xx : 31 - xx;
                if (type == 0) fox_sp32_unit(lds, Qb, Kb, VTb, C2, Ob, b, h, qb, tid, wave, lane);
                else attn_unit<1>(lds, Qb + (size_t)MREAL * HW, Kb + KV_STRIDE / 2, VTb + KV_STRIDE / 2, C2, Ob + (size_t)MREAL * HW, b, h, qb, tid, wave, lane); }
        }
    }
    SEAM(6);
    if (IN(7)) REPS(7) {
        pg8::Gemm g{Ob, Wbf, MREAL, DM, HW, (size_t)MREAL * HW * 2, (size_t)DM * HW * 2}; BranchOrder S; S.S.init(MREAL, DM, G, bx);
        EpiBranch E{Gt, MRG};
        pg8::gemm_phase<EpiBranch, BranchOrder, true, true>(lds, g, S, E);
    }
    SEAM(7);
    if (IN(8)) REPS(8) {
        pg8::Gemm g{MRG, Wout, MREAL, DM, DM, 0, 0}; pg8::StaticOrder S; S.init(MREAL, DM, G, bx);
        EpiResid E{out, out, out, out, 1.0f, MREAL};
        pg8::gemm_phase<EpiResid, pg8::StaticOrder, true, true>(lds, g, S, E);
    }
    SEAM(8);
    if (IN(9)) REPS(9) {
        for (int r = gw; r < MREAL; r += NGW) { f32x4 v[8]; rms_row(out + (size_t)r * DM, nullptr, 0.f, a.in[14], XN + (size_t)r * DM, lane, v); }
        {
            constexpr int I_GU = (DM / 64) * (FF / 64); LAS float* scr = (LAS float*)(lds + wave * 16640);
            for (int r = gw; r < I_GU; r += NGW) tr_seg(a.in[16], FF, DM, FF, 0, Wgu2, 2, 0, r, scr, lane);
        }
    }
    SEAM(9);
    if (IN(10)) REPS(10) {
#ifndef REP_GEMM10
#define REP_GEMM10 1
#endif
#ifndef EXTRA_SYNCS
#define EXTRA_SYNCS 0
#endif
        pg8::Gemm g{XN, Wgu2, MREAL, 2 * FF, DM, 0, 0}; RepOrder<pg8::StaticOrder, REP_GEMM10> S; S.S.init(MREAL, 2 * FF, G, bx); S.count();
        EpiSwiglu E{U};
        pg8::gemm_phase<EpiSwiglu, RepOrder<pg8::StaticOrder, REP_GEMM10>, true, true>(lds, g, S, E);
        {
            const int rem = S.S.nwg % G; constexpr int I_D = (FF / 64) * (DM / 64);
            LAS float* scr = (LAS float*)(lds + wave * 16640);
            if (rem != 0 && bx >= rem) { for (int r = (bx - rem) * 8 + wave; r < I_D; r += (G - rem) * 8) tr_seg(a.in[17], DM, FF, DM, 0, Wd2, 0, 0, r, scr, lane); }
            else if (rem == 0) { for (int r = gw; r < I_D; r += NGW) tr_seg(a.in[17], DM, FF, DM, 0, Wd2, 0, 0, r, scr, lane); }
        }
        for (int es = 0; es < EXTRA_SYNCS; ++es) xcd_barrier(xbar);
    }
    SEAM(10);
    if (IN(11)) REPS(11) {
        pg8::Gemm g{U, Wd2, MREAL, DM, FF, 0, 0}; pg8::StaticOrder S; S.init(MREAL, DM, G, bx);
        EpiResid E{out, out, out, out, 0.5f, MREAL};
        pg8::gemm_phase<EpiResid, pg8::StaticOrder, true, true>(lds, g, S, E);
    }
#undef IN
#undef SEAM
}

extern "C" void kernel_launch(void* const* d_in, const int* in_sizes, int n_in, void* d_out, int out_size, void* d_ws, size_t ws_size, hipStream_t stream) {
    static int grid = 0;
    if (grid == 0) {
        if (n_in != 18 || in_sizes[0] != MREAL * DM || out_size != MREAL * DM || ws_size < WS_END) {
            fprintf(stderr, "kernel_launch: unexpected shapes: n_in %d in0 %d out %d ws %zu (need %zu)\n", n_in, n_in > 0 ? in_sizes[0] : -1, out_size, ws_size, (size_t)WS_END); grid = -1; return; }
        int dev = 0, cus = 0, per_cu = 0;
        if (hipGetDevice(&dev) != hipSuccess || hipDeviceGetAttribute(&cus, hipDeviceAttributeMultiprocessorCount, dev) != hipSuccess) { grid = -1; return; }
        if (hipFuncSetAttribute((const void*)mk_fwd, hipFuncAttributeMaxDynamicSharedMemorySize, LDS_BYTES) != hipSuccess) { fprintf(stderr, "kernel_launch: hipFuncSetAttribute failed\n"); grid = -1; return; }
        if (hipOccupancyMaxActiveBlocksPerMultiprocessor(&per_cu, (const void*)mk_fwd, 512, LDS_BYTES) != hipSuccess || per_cu < 1) { fprintf(stderr, "kernel_launch: occupancy query says %d\n", per_cu); per_cu = 1; }
        (void)hipGetLastError();
        grid = cus * per_cu;
    }
    if (grid < 0) return;
    Args a{};
    for (int i = 0; i < 18; ++i) a.in[i] = (const float*)d_in[i];
    a.out = (float*)d_out; a.ws = (unsigned char*)d_ws;
#if MK_N_LAUNCHES == 1
    if (hipMemsetAsync(d_ws, 0, 16384, stream) != hipSuccess) { fprintf(stderr, "kernel_launch: memset of the barrier words failed\n"); return; }
    a.ph_lo = 0; a.ph_hi = NPHASE;
    void* args[] = {&a};
    hipError_t e = hipLaunchCooperativeKernel((const void*)mk_fwd, dim3(grid), dim3(512), args, LDS_BYTES, stream);
    if (e != hipSuccess) fprintf(stderr, "kernel_launch: cooperative launch failed: %s (grid %d)\n", hipGetErrorString(e), grid);
#else
    for (int p = 0; p < NPHASE; ++p) { a.ph_lo = p; a.ph_hi = p + 1; hipLaunchKernelGGL(mk_fwd, dim3(grid), dim3(512), LDS_BYTES, stream, a); }
#endif
}
```

```cpp
#include <hip/hip_runtime.h>
#include <hip/hip_cooperative_groups.h>
#include <cstdio>
#include <cstdint>
#include <cmath>
namespace cg = cooperative_groups;
namespace pg8 {
#define PG8_LAS __attribute__((address_space(3)))
typedef unsigned short bf16_t;
typedef short bf16x8 __attribute__((ext_vector_type(8)));
typedef float f32x4 __attribute__((ext_vector_type(4)));
typedef unsigned u32x4 __attribute__((ext_vector_type(4)));
constexpr int BM = 256, BK = 64, HALF = 128, HTB = HALF * BK * 2  , STAGE_BYTES = 8 * HTB, NXCD = 8, WGM = 8;

__host__ __device__ __forceinline__ int lds_byte(int r, int c) { const int st = (r >> 4) * 2 + (c >> 5), rr = r & 15, cc = c & 31, ob = rr * 64 + cc * 2; return st * 1024 + (ob ^ (((ob >> 9) & 1) << 5)); }
__host__ __device__ __forceinline__ void stage_rc(int b, int& R, int& C) { const int st = b / 1024, sb = b % 1024, swz = sb ^ (((sb >> 9) & 1) << 5); R = (st >> 1) * 16 + swz / 64; C = (st & 1) * 32 + (swz % 64) / 2; }
__host__ __device__ __forceinline__ int perm32(int rho) { const int n = rho >> 4, i = rho & 15; return 8 * (i >> 2) + 4 * n + (i & 3); }

struct Unit { int pm, pn, z, nt; };
struct Gemm { const bf16_t* A; const bf16_t* Bt; int M, N, K; size_t zA, zB; };

struct StaticOrder {
    int nM, nN, nwg, G, c;
    __host__ __device__ void init(int M, int N, int G_, int c_) { nM = M / BM; nN = N / BM; nwg = nM * nN; G = G_; c = c_; }
    __host__ __device__ bool next(int i, Unit& u) const {
        const long L = (long)i * G + c; if (L >= nwg) return false;
        int wgid = (int)L; { const int q = nwg / NXCD, r = nwg % NXCD, xcd = wgid % NXCD, off = wgid / NXCD; wgid = (xcd < r ? xcd * (q + 1) : r * (q + 1) + (xcd - r) * q) + off; }
        const int nig = WGM * nN, gid = wgid / nig, fm = gid * WGM, gsz = (nM - fm) < WGM ? (nM - fm) : WGM;
        u.pm = fm + ((wgid % nig) % gsz); u.pn = (wgid % nig) / gsz; u.z = 0; u.nt = 0; return true;
    }
    __device__ __forceinline__ void a_ready(const Unit&) const {}
    __device__ __forceinline__ void done(const Unit&) const {}
};


__device__ __forceinline__ unsigned cvt_pk_bf16(float lo, float hi) { unsigned r; asm volatile("s_nop 0\n\tv_cvt_pk_bf16_f32 %0, %1, %2" : "=v"(r) : "v"(lo), "v"(hi)); return r; }
template <class Epi, class Sched, bool ALIGN_EPI = false, bool SP2 = false>
__device__ __forceinline__ void gemm_phase(PG8_LAS unsigned char* lds, const Gemm g, const Sched& S, const Epi& E) {
    const int tid = threadIdx.x, wid = __builtin_amdgcn_readfirstlane(tid >> 6), lane = tid & 63, wr = wid >> 2, wc = wid & 3, fr = lane & 15, fq = lane >> 4;
    const int K = g.K, nt = K / BK;
    unsigned voffA[2], voffB[2];
#pragma unroll
    for (int i = 0; i < 2; ++i) { int R, C; stage_rc(tid * 16 + i * 8192, R, C); const int Rb = Epi::PERM ? ((R & ~31) + perm32(R & 31)) : R;
        voffA[i] = (unsigned)(R * K + C) * 2u; voffB[i] = (unsigned)(Rb * K + C) * 2u; }
    const size_t kstep = (size_t)(BK * 2);
    const size_t hstep = (size_t)HALF * K * 2;
    const size_t tstep = 2 * hstep;
    const unsigned ldsw = (unsigned)wid * 1024u;
    const int aoff = lds_byte(wr * 64 + fr, fq * 8), boff = lds_byte(wc * 32 + fr, fq * 8);
#define PG8_SA(b, h) (((b) * 2 + (h)) * HTB)
#define PG8_SB(b, h) ((4 + (b) * 2 + (h)) * HTB)
#define PG8_STAGE(bufoff, gbase, voff) do { _Pragma("unroll") for (int _i = 0; _i < 2; ++_i) \
        __builtin_amdgcn_global_load_lds((const unsigned*)((const char*)(gbase) + (voff)[_i]), (PG8_LAS unsigned*)(lds + (bufoff) + ldsw + _i * 8192), 16, 0, 0); } while (0)
#define PG8_LDA(dst, b, h) do { _Pragma("unroll") for (int m = 0; m < 4; ++m) _Pragma("unroll") for (int k = 0; k < 2; ++k) dst[m][k] = *(const PG8_LAS bf16x8*)(lds + PG8_SA(b, h) + aoff + m * 2048 + k * 1024); } while (0)
#define PG8_LDB(dst, b, h) do { _Pragma("unroll") for (int n = 0; n < 2; ++n) _Pragma("unroll") for (int k = 0; k < 2; ++k) dst[n][k] = *(const PG8_LAS bf16x8*)(lds + PG8_SB(b, h) + boff + n * 2048 + k * 1024); } while (0)
#define PG8_MMA(ai, bj, At, Bt) do { __builtin_amdgcn_s_setprio(1); _Pragma("unroll") for (int m = 0; m < 4; ++m) _Pragma("unroll") for (int n = 0; n < 2; ++n) _Pragma("unroll") for (int k = 0; k < 2; ++k) \
        acc[ai][bj][m][n] = __builtin_amdgcn_mfma_f32_16x16x32_bf16(Bt[n][k], At[m][k], acc[ai][bj][m][n], 0, 0, 0); __builtin_amdgcn_s_setprio(0); } while (0)
#define PG8_WAIT_V(n) asm volatile("s_waitcnt vmcnt(" #n ")" ::: "memory")
#define PG8_WAIT_L(n) asm volatile("s_waitcnt lgkmcnt(" #n ")" ::: "memory")
#define PG8_BAR __builtin_amdgcn_s_barrier()
#define PG8_SCHED __builtin_amdgcn_sched_barrier(0)
    Unit cur, nxt; int ui = 0;
    if (!S.next(0, cur)) return;
    f32x4 acc[2][2][4][2];
#pragma unroll
    for (int a = 0; a < 2; ++a)
#pragma unroll
        for (int b = 0; b < 2; ++b)
#pragma unroll
            for (int m = 0; m < 4; ++m)
#pragma unroll
                for (int n = 0; n < 2; ++n) acc[a][b][m][n] = (f32x4){0.f, 0.f, 0.f, 0.f};
    bf16x8 At[4][2], B0[2][2], B1[2][2];
    const char* cA = (const char*)g.A + (size_t)cur.pm * tstep + (size_t)cur.z * g.zA; const char* cB = (const char*)g.Bt + (size_t)cur.pn * tstep + (size_t)cur.z * g.zB;
    S.a_ready(cur);
    if constexpr (SP2) {
        PG8_STAGE(PG8_SB(0, 0), cB, voffB); PG8_STAGE(PG8_SB(0, 1), cB + hstep, voffB); PG8_STAGE(PG8_SA(0, 0), cA, voffA); PG8_STAGE(PG8_SA(0, 1), cA + hstep, voffA);
        if (wr == 1) PG8_BAR;
        PG8_WAIT_V(2); PG8_BAR;
        PG8_STAGE(PG8_SB(1, 0), cB + kstep, voffB); PG8_STAGE(PG8_SA(1, 0), cA + kstep, voffA); PG8_STAGE(PG8_SB(1, 1), cB + hstep + kstep, voffB);
        PG8_WAIT_V(6); PG8_BAR;
    } else {
        PG8_STAGE(PG8_SB(0, 0), cB, voffB); PG8_STAGE(PG8_SA(0, 0), cA, voffA); PG8_STAGE(PG8_SB(0, 1), cB + hstep, voffB); PG8_STAGE(PG8_SA(0, 1), cA + hstep, voffA);
        if (wr == 1) PG8_BAR;
        PG8_WAIT_V(4); PG8_BAR;
        PG8_STAGE(PG8_SB(1, 0), cB + kstep, voffB); PG8_STAGE(PG8_SA(1, 0), cA + kstep, voffA); PG8_STAGE(PG8_SB(1, 1), cB + hstep + kstep, voffB);
        PG8_WAIT_V(6); PG8_BAR;
    }
    for (;;) {
        const bool has_next = S.next(ui + 1, nxt);
        const char* nA = has_next ? (const char*)g.A + (size_t)nxt.pm * tstep + (size_t)nxt.z * g.zA : cA; const char* nB = has_next ? (const char*)g.Bt + (size_t)nxt.pn * tstep + (size_t)nxt.z * g.zB : cB;
        const int unt = cur.nt ? cur.nt : nt;
        for (int t = 0; t < unt; t += 2) {
            const bool last = (t == unt - 2);
            const char* a1 = cA + (size_t)(t + 1) * kstep;
            const char* a2 = last ? nA : cA + (size_t)(t + 2) * kstep; const char* b2 = last ? nB : cB + (size_t)(t + 2) * kstep;
            const char* a3 = a2 + kstep; const char* b3 = b2 + kstep;
            if (last && has_next) S.a_ready(nxt);
            if constexpr (SP2) {
            PG8_LDB(B0, 0, 0); PG8_LDB(B1, 0, 1); PG8_SCHED; PG8_LDA(At, 0, 0); PG8_STAGE(PG8_SA(1, 1), a1 + hstep, voffA);
            PG8_WAIT_V(8); PG8_WAIT_L(0); PG8_BAR; PG8_MMA(0, 0, At, B0); PG8_MMA(0, 1, At, B1); PG8_BAR; PG8_SCHED;
            PG8_LDA(At, 0, 1); PG8_STAGE(PG8_SB(0, 0), b2, voffB); PG8_STAGE(PG8_SB(0, 1), b2 + hstep, voffB); PG8_STAGE(PG8_SA(0, 0), a2, voffA);
            PG8_WAIT_V(8); PG8_WAIT_L(0); PG8_BAR; PG8_MMA(1, 0, At, B0); PG8_MMA(1, 1, At, B1); PG8_BAR; PG8_SCHED;
            PG8_LDB(B0, 1, 0); PG8_LDB(B1, 1, 1); PG8_SCHED; PG8_LDA(At, 1, 0); PG8_STAGE(PG8_SA(0, 1), a2 + hstep, voffA);
            PG8_WAIT_V(8); PG8_WAIT_L(0); PG8_BAR; PG8_MMA(0, 0, At, B0); PG8_MMA(0, 1, At, B1); PG8_BAR; PG8_SCHED;
            PG8_LDA(At, 1, 1); PG8_STAGE(PG8_SB(1, 0), b3, voffB); PG8_STAGE(PG8_SB(1, 1), b3 + hstep, voffB); PG8_STAGE(PG8_SA(1, 0), a3, voffA);
            PG8_WAIT_V(8); PG8_WAIT_L(0); PG8_BAR; PG8_MMA(1, 0, At, B0); PG8_MMA(1, 1, At, B1); PG8_BAR; PG8_SCHED;
            } else {
            PG8_LDB(B0, 0, 0); PG8_SCHED; PG8_LDA(At, 0, 0); PG8_STAGE(PG8_SA(1, 1), a1 + hstep, voffA);
            PG8_WAIT_L(8); PG8_BAR; PG8_WAIT_L(0); PG8_MMA(0, 0, At, B0); PG8_BAR; PG8_SCHED;
            PG8_LDB(B1, 0, 1); PG8_STAGE(PG8_SB(0, 0), b2, voffB);
            PG8_BAR; PG8_WAIT_L(0); PG8_MMA(0, 1, At, B1); PG8_BAR;
            PG8_LDA(At, 0, 1); PG8_STAGE(PG8_SA(0, 0), a2, voffA);
            PG8_BAR; PG8_WAIT_L(0); PG8_MMA(1, 0, At, B0); PG8_BAR; PG8_SCHED;
            PG8_STAGE(PG8_SB(0, 1), b2 + hstep, voffB);
            PG8_WAIT_V(6); PG8_BAR; PG8_MMA(1, 1, At, B1); PG8_BAR;
            PG8_LDB(B0, 1, 0); PG8_SCHED; PG8_LDA(At, 1, 0); PG8_STAGE(PG8_SA(0, 1), a2 + hstep, voffA);
            PG8_WAIT_L(8); PG8_BAR; PG8_WAIT_L(0); PG8_MMA(0, 0, At, B0); PG8_BAR; PG8_SCHED;
            PG8_LDB(B1, 1, 1); PG8_STAGE(PG8_SB(1, 0), b3, voffB);
            PG8_BAR; PG8_WAIT_L(0); PG8_MMA(0, 1, At, B1); PG8_BAR;
            PG8_LDA(At, 1, 1); PG8_STAGE(PG8_SA(1, 0), a3, voffA);
            PG8_BAR; PG8_WAIT_L(0); PG8_MMA(1, 0, At, B0); PG8_BAR; PG8_SCHED;
            PG8_STAGE(PG8_SB(1, 1), b3 + hstep, voffB);
            PG8_WAIT_V(6); PG8_BAR; PG8_MMA(1, 1, At, B1); PG8_BAR;
            }
        }
        if constexpr (ALIGN_EPI) { if (wr == 0) PG8_BAR; }
        if constexpr (!Epi::AFTER_DRAIN) { E(acc, cur, wr, wc, fr, fq); S.done(cur); }
        if (!has_next) break;
#pragma unroll
        for (int a = 0; a < 2; ++a)
#pragma unroll
            for (int b = 0; b < 2; ++b)
#pragma unroll
                for (int m = 0; m < 4; ++m)
#pragma unroll
                    for (int n = 0; n < 2; ++n) acc[a][b][m][n] = (f32x4){0.f, 0.f, 0.f, 0.f};
        cur = nxt; cA = nA; cB = nB; ++ui;
        if constexpr (ALIGN_EPI) { if (wr == 1) PG8_BAR; }
    }
    PG8_WAIT_V(0);
    if constexpr (!ALIGN_EPI) { if (wr == 0) PG8_BAR; }
    PG8_BAR;
    if constexpr (Epi::AFTER_DRAIN) { E.fused(acc, cur, wr, wc, fr, fq, lds, wid, lane); S.done(cur); }
#undef PG8_SA
#undef PG8_SB
#undef PG8_STAGE
#undef PG8_LDA
#undef PG8_LDB
#undef PG8_MMA
#undef PG8_WAIT_V
#undef PG8_WAIT_L
#undef PG8_BAR
#undef PG8_SCHED
}
}

constexpr int DM = 2048, FF = 5632, SEQ = 4096, NB = 2, NMETA = 16, HD = 128, NH = 8, HW = 1024;
constexpr int MREAL = NB * SEQ;
constexpr int MALL = MREAL + NMETA;
constexpr int MPAD = 8448;
constexpr int LSEQ = 4160;
constexpr int LLOG = NMETA + SEQ;
constexpr int NIN = 10240;
constexpr int WIN_LD = 10248;
constexpr float RMS_EPS = 1e-6f;
constexpr float LOG2E = 1.4426950408889634f;
constexpr int NPHASE = 12;
#ifndef MK_N_LAUNCHES
#define MK_N_LAUNCHES 1
#endif

constexpr size_t MiB = 1u << 20;
constexpr size_t WS_WGU1 = 1 * MiB, WS_WD1 = 45 * MiB, WS_WGU2 = 67 * MiB, WS_WD2 = 111 * MiB, WS_WIN = 133 * MiB, WS_WBF = 173 * MiB, WS_WBS = 177 * MiB, WS_WOUT = 181 * MiB;
constexpr size_t WS_XN = 189 * MiB;
constexpr size_t WS_U = 222 * MiB;
constexpr size_t WS_G = WS_U;
constexpr size_t WS_Q = 313 * MiB;
constexpr size_t WS_MRG = WS_Q;
constexpr size_t WS_K = 345 * MiB;
constexpr size_t WS_VT = 379 * MiB;
constexpr size_t WS_O = WS_XN;
constexpr size_t WS_MISC = 413 * MiB;
constexpr size_t WS_END = 415 * MiB;
constexpr size_t KV_STRIDE = 17 * MiB;
constexpr size_t MISC_LOGF = 128 * 1024, MISC_C2 = 512 * 1024, MISC_KVM = 1024 * 1024;

constexpr int LDS_BYTES = 147456;

#define GAS __attribute__((address_space(1)))
#define LAS __attribute__((address_space(3)))
typedef unsigned short bf16;
typedef unsigned v4u __attribute__((ext_vector_type(4)));
typedef unsigned v2u __attribute__((ext_vector_type(2)));
typedef float f32x4 __attribute__((ext_vector_type(4)));
typedef short bf16x8 __attribute__((ext_vector_type(8)));
#define LDS_WAIT() asm volatile("s_waitcnt lgkmcnt(0)" ::: "memory")

__device__ __forceinline__ unsigned pk2(float lo, float hi) { return pg8::cvt_pk_bf16(lo, hi); }
__device__ __forceinline__ float bf_lo(unsigned w) { return __uint_as_float(w << 16); }
__device__ __forceinline__ float bf_hi(unsigned w) { return __uint_as_float(w & 0xffff0000u); }
__device__ __forceinline__ float wave_sum(float v) {
#pragma unroll
    for (int o = 1; o < 64; o <<= 1) v += __shfl_xor(v, o);
    return v;
}
__device__ __forceinline__ float fast_sigmoid(float v) { return __builtin_amdgcn_rcpf(1.0f + __builtin_amdgcn_exp2f(-v * LOG2E)); }
__device__ __forceinline__ float log_sigmoid_acc(float x) { return fminf(x, 0.f) - log1pf(expf(-fabsf(x))); }

__device__ __forceinline__ void tr_item(const float* W, int ldw, int K, int n_src, bf16* WT, int drow, LAS float* scr, int k0, int lane) {
    const int kr = lane >> 4, nc = lane & 15;
    f32x4 v[16];
#pragma unroll
    for (int i = 0; i < 16; ++i) v[i] = *(const f32x4*)(W + (size_t)(k0 + 4 * i + kr) * ldw + n_src + 4 * nc);
#pragma unroll
    for (int i = 0; i < 16; ++i) { LAS float* d = scr + (4 * i + kr) * 65 + 4 * nc; d[0] = v[i].x; d[1] = v[i].y; d[2] = v[i].z; d[3] = v[i].w; }
    LDS_WAIT(); asm volatile("" ::: "memory");
    const int c = lane & 7;
#pragma unroll
    for (int j = 0; j < 8; ++j) { const int n = (lane >> 3) + 8 * j; const LAS float* s = scr + (8 * c) * 65 + n;
        v4u o; o.x = pk2(s[0 * 65], s[1 * 65]); o.y = pk2(s[2 * 65], s[3 * 65]); o.z = pk2(s[4 * 65], s[5 * 65]); o.w = pk2(s[6 * 65], s[7 * 65]);
        *(v4u*)(WT + (size_t)(drow + n) * K + k0 + 8 * c) = o; }
    LDS_WAIT(); asm volatile("" ::: "memory");
}
__device__ __forceinline__ void tr_seg(const float* W, int ldw, int K, int ncols, int n_src0, bf16* WT, int mode, int drow0, int r, LAS float* scr, int lane) {
    const int nblk = ncols >> 6, kb = r / nblk, nb = r - kb * nblk, n0 = nb * 64;
    const int drow = mode == 0 ? drow0 + n0 : ((n0 >> 7) << 8) + (n0 & 127) + (mode == 2 ? 128 : 0);
    tr_item(W, ldw, K, n_src0 + n0, WT, drow, scr, kb * 64, lane);
}
__device__ __forceinline__ void rms_row(const float* src, const float* add, float alpha, const float* gain, bf16* dst, int lane, f32x4 (&v)[8]) {
    float ss = 0.f;
#pragma unroll
    for (int j = 0; j < 8; ++j) { v[j] = ((const f32x4*)src)[lane + 64 * j]; if (add) v[j] = v[j] + ((const f32x4*)add)[lane + 64 * j] * alpha; ss += (v[j].x * v[j].x + v[j].y * v[j].y) + (v[j].z * v[j].z + v[j].w * v[j].w); }
    const float rstd = 1.0f / sqrtf(wave_sum(ss) * (1.0f / DM) + RMS_EPS);
#pragma unroll
    for (int j = 0; j < 8; ++j) { const f32x4 g = ((const f32x4*)gain)[lane + 64 * j]; v[j] = v[j] * rstd * g;
        v2u o; o.x = pk2(v[j].x, v[j].y); o.y = pk2(v[j].z, v[j].w); ((v2u*)dst)[lane + 64 * j] = o; }
}

struct EpiSwiglu {
    static constexpr bool PERM = true, AFTER_DRAIN = false; bf16* U;
    __device__ __forceinline__ void operator()(const f32x4 (&acc)[2][2][4][2], const pg8::Unit& u, int wr, int wc, int fr, int fq) const {
        const int row0 = u.pm * 256 + wr * 64 + fr, col = u.pn * 128 + wc * 32 + 8 * fq;
#pragma unroll
        for (int ai = 0; ai < 2; ++ai)
#pragma unroll
            for (int m = 0; m < 4; ++m) {
                const f32x4 g0 = acc[ai][0][m][0], g1 = acc[ai][0][m][1], u0 = acc[ai][1][m][0], u1 = acc[ai][1][m][1];
                f32x4 r0, r1;
#pragma unroll
                for (int e = 0; e < 4; ++e) { r0[e] = g0[e] * fast_sigmoid(g0[e]) * u0[e]; r1[e] = g1[e] * fast_sigmoid(g1[e]) * u1[e]; }
                v4u w; w.x = pk2(r0[0], r0[1]); w.y = pk2(r0[2], r0[3]); w.z = pk2(r1[0], r1[1]); w.w = pk2(r1[2], r1[3]);
                *(v4u*)(U + (size_t)(row0 + ai * 128 + m * 16) * FF + col) = w; }
    }
};
struct EpiResid {
    static constexpr bool PERM = false, AFTER_DRAIN = false;
    const float* base_real; const float* base_meta; float* out_real; float* out_meta; float alpha; int mvalid;
    __device__ __forceinline__ void operator()(const f32x4 (&acc)[2][2][4][2], const pg8::Unit& u, int wr, int wc, int fr, int fq) const {
        const int col0 = u.pn * 256 + wc * 32 + 4 * fq;
#pragma unroll
        for (int ai = 0; ai < 2; ++ai)
#pragma unroll
            for (int m = 0; m < 4; ++m) {
                const int row = u.pm * 256 + ai * 128 + wr * 64 + m * 16 + fr;
                if (row >= mvalid) continue;
                if (row >= MREAL) {
                    float* op = out_meta + (size_t)(row - MREAL) * DM;
#pragma unroll
                    for (int bj = 0; bj < 2; ++bj)
#pragma unroll
                        for (int n = 0; n < 2; ++n) { const int c = col0 + bj * 128 + n * 16;
#pragma unroll
                            for (int e = 0; e < 4; ++e) atomicAdd(op + c + e, acc[ai][bj][m][n][e]); }
                    continue; }
                const float* bp = row < MREAL ? base_real + (size_t)row * DM : base_meta + (size_t)(row - MREAL) * DM;
                float* op = row < MREAL ? out_real + (size_t)row * DM : out_meta + (size_t)(row - MREAL) * DM;
#pragma unroll
                for (int bj = 0; bj < 2; ++bj)
#pragma unroll
                    for (int n = 0; n < 2; ++n) { const int c = col0 + bj * 128 + n * 16; const f32x4 bs = *(const f32x4*)(bp + c); *(f32x4*)(op + c) = bs + acc[ai][bj][m][n] * alpha; }
            }
    }
};
struct EpiInproj {
    static constexpr bool PERM = true, AFTER_DRAIN = false;
    bf16* Q; bf16* K; bf16* VT; bf16* G; float* KVM;
    __device__ __forceinline__ void operator()(const f32x4 (&acc)[2][2][4][2], const pg8::Unit& u, int wr, int wc, int fr, int fq) const {
        const int pn = u.pn;
        const int which = (pn >= 12 && pn < 24) ? 1 : 0;
        const int kind = pn >= 24 ? 3 : ((pn - which * 12) >> 2);
        const int ct = kind == 3 ? (pn - 24) : ((pn - which * 12) & 3);
        if (u.pm == 32) {
            if (wr == 0) {
                const int cbase = (which * 2 + (kind - 1)) * 1024 + ct * 256 + wc * 32 + 8 * fq;
#pragma unroll
                for (int bj = 0; bj < 2; ++bj)
#pragma unroll
                    for (int n = 0; n < 2; ++n)
#pragma unroll
                        for (int e = 0; e < 4; ++e) atomicAdd(KVM + (size_t)fr * 4096 + cbase + bj * 128 + 4 * n + e, acc[0][bj][0][n][e]);
            }
            return;
        }
#pragma unroll
        for (int ai = 0; ai < 2; ++ai)
#pragma unroll
            for (int m = 0; m < 4; ++m) {
                const int row = u.pm * 256 + ai * 128 + wr * 64 + m * 16 + fr;
                if (row >= MALL) continue;
                const bool meta = row >= MREAL;
                const int b = row >> 12, t = row & 4095, mi = row - MREAL;
#pragma unroll
                for (int bj = 0; bj < 2; ++bj) {
                    const int col = ct * 256 + bj * 128 + wc * 32 + 8 * fq;
                    const f32x4 v0 = acc[ai][bj][m][0], v1 = acc[ai][bj][m][1];
                    if (kind == 3) {
                        if (!meta) { v4u w; w.x = pk2(fast_sigmoid(v0[0]), fast_sigmoid(v0[1])); w.y = pk2(fast_sigmoid(v0[2]), fast_sigmoid(v0[3]));
                            w.z = pk2(fast_sigmoid(v1[0]), fast_sigmoid(v1[1])); w.w = pk2(fast_sigmoid(v1[2]), fast_sigmoid(v1[3]));
                            *(v4u*)(G + (size_t)row * 4096 + col) = w; }
                    } else if (kind == 0) {
                        if (!meta) { v4u w; w.x = pk2(v0[0], v0[1]); w.y = pk2(v0[2], v0[3]); w.z = pk2(v1[0], v1[1]); w.w = pk2(v1[2], v1[3]);
                            *(v4u*)(Q + (size_t)which * ((size_t)MREAL * HW) + (size_t)row * HW + col) = w; }
                    } else if (kind == 1) {
                        v4u w; w.x = pk2(v0[0], v0[1]); w.y = pk2(v0[2], v0[3]); w.z = pk2(v1[0], v1[1]); w.w = pk2(v1[2], v1[3]);
                        bf16* kb = K + (size_t)which * (KV_STRIDE / 2);
                        if (!meta) *(v4u*)(kb + (size_t)(b * LSEQ + 64 + t) * HW + col) = w;
                        else { *(v4u*)(kb + (size_t)mi * HW + col) = w; *(v4u*)(kb + (size_t)(LSEQ + mi) * HW + col) = w; }
                    } else {
                        bf16* vb = VT + (size_t)which * (KV_STRIDE / 2);
                        const int h = col >> 7, d0 = col & 127;
#pragma unroll
                        for (int e = 0; e < 8; ++e) {
                            const float val = e < 4 ? v0[e & 3] : v1[e & 3];
                            const bf16 hv = (bf16)(pk2(val, 0.f) & 0xffffu);
                            if (!meta) vb[(size_t)((b * NH + h) * HD + d0 + e) * LSEQ + 64 + t] = hv;
                            else { vb[(size_t)((0 * NH + h) * HD + d0 + e) * LSEQ + mi] = hv; vb[(size_t)((1 * NH + h) * HD + d0 + e) * LSEQ + mi] = hv; }
                        }
                    }
                }
            }
    }
};
struct EpiBranch {
    static constexpr bool PERM = true, AFTER_DRAIN = false;
    const bf16* G; bf16* MRG;
    __device__ __forceinline__ void operator()(const f32x4 (&acc)[2][2][4][2], const pg8::Unit& u, int wr, int wc, int fr, int fq) const {
#pragma unroll
        for (int ai = 0; ai < 2; ++ai)
#pragma unroll
            for (int m = 0; m < 4; ++m) {
                const int row = u.pm * 256 + ai * 128 + wr * 64 + m * 16 + fr;
#pragma unroll
                for (int bj = 0; bj < 2; ++bj) {
                    const int col = u.pn * 256 + bj * 128 + wc * 32 + 8 * fq;
                    const v4u g = *(const v4u*)(G + (size_t)row * 4096 + u.z * 2048 + col);
                    bf16* mp = MRG + (size_t)row * DM + col;
                    v4u pv = (v4u){0u, 0u, 0u, 0u}; if (u.z) pv = *(const v4u*)mp;
                    const f32x4 v0 = acc[ai][bj][m][0], v1 = acc[ai][bj][m][1];
                    v4u w;
                    w.x = pk2(bf_lo(pv.x) + bf_lo(g.x) * v0[0], bf_hi(pv.x) + bf_hi(g.x) * v0[1]);
                    w.y = pk2(bf_lo(pv.y) + bf_lo(g.y) * v0[2], bf_hi(pv.y) + bf_hi(g.y) * v0[3]);
                    w.z = pk2(bf_lo(pv.z) + bf_lo(g.z) * v1[0], bf_hi(pv.z) + bf_hi(g.z) * v1[1]);
                    w.w = pk2(bf_lo(pv.w) + bf_lo(g.w) * v1[2], bf_hi(pv.w) + bf_hi(g.w) * v1[3]);
                    *(v4u*)mp = w;
                }
            }
    }
};

struct InprojOrder {
    pg8::StaticOrder S;
    __device__ __forceinline__ bool next(int i, pg8::Unit& u) const {
        const long L = (long)i * S.G + S.c;
        if (L < S.nwg) return S.next(i, u);
        const int e = (int)(L - S.nwg); if (e >= 128) return false;
        const int ct = e & 15; u.pm = 32; u.pn = ct < 8 ? 4 + ct : 8 + ct; u.z = e >> 4; u.nt = 4; return true;
    }
    __device__ __forceinline__ void a_ready(const pg8::Unit&) const {}
    __device__ __forceinline__ void done(const pg8::Unit&) const {}
};
struct DownOrder {
    pg8::StaticOrder S;
    __device__ __forceinline__ bool next(int i, pg8::Unit& u) const {
        const long L = (long)i * S.G + S.c;
        if (L < S.nwg) return S.next(i, u);
        const int e = (int)(L - S.nwg); if (e >= 176) return false;
        u.pm = 32; u.pn = e & 7; u.z = e >> 3; u.nt = 4; return true;
    }
    __device__ __forceinline__ void a_ready(const pg8::Unit&) const {}
    __device__ __forceinline__ void done(const pg8::Unit&) const {}
};
template <class Sch, int REPN> struct RepOrder {
    Sch S; int nc;
    __device__ __forceinline__ void count() { pg8::Unit u; nc = 0; while (S.next(nc, u)) ++nc; }
    __device__ __forceinline__ bool next(int i, pg8::Unit& u) const { if (nc == 0 || i >= REPN * nc) return false; return S.next(i % nc, u); }
    __device__ __forceinline__ void a_ready(const pg8::Unit&) const {}
    __device__ __forceinline__ void done(const pg8::Unit&) const {}
};
struct BranchOrder {
    pg8::StaticOrder S;
    __device__ __forceinline__ bool next(int i, pg8::Unit& u) const { if (!S.next(i >> 1, u)) return false; u.z = i & 1; return true; }
    __device__ __forceinline__ void a_ready(const pg8::Unit&) const {}
    __device__ __forceinline__ void done(const pg8::Unit&) const {}
};

template <int TYPE>
__device__ __forceinline__ void attn_unit(LAS unsigned char* lds, const bf16* Qb, const bf16* Kb, const bf16* VTb, const float* c2, bf16* Ob, int b, int h, int qb, int tid, int wave, int lane) {
    const int fr = lane & 15, fq = lane >> 4;
    LAS unsigned char* ldsK = lds; LAS unsigned char* ldsV = lds + 17408; volatile LAS int* flags = (volatile LAS int*)(lds + 36864);
    const int t0 = qb * 128, tq = t0 + wave * 16 + fr, qpos = 64 + tq;
    const int qmin = 64 + t0 + wave * 16, qmax = qmin + 15;
    const bf16* qrow = Qb + (size_t)(b * SEQ + tq) * HW + h * HD + fq * 8;
    bf16x8 qf[4];
#pragma unroll
    for (int kk = 0; kk < 4; ++kk) qf[kk] = *(const bf16x8*)(qrow + 32 * kk);
    f32x4 o[8];
#pragma unroll
    for (int n = 0; n < 8; ++n) o[n] = (f32x4){0.f, 0.f, 0.f, 0.f};
    float m_run = -INFINITY, l_run = 0.f, R = 0.f;
    const float* c2row = c2 + (size_t)(b * NH + h) * LSEQ;
    float cq = 0.f; if (TYPE == 0) cq = c2row[qpos];
    const unsigned char* Kg = (const unsigned char*)(Kb + (size_t)(b * LSEQ) * HW + h * HD) + (size_t)(tid >> 4) * 2048 + (tid & 15) * 16;
    const unsigned char* Vg = (const unsigned char*)(VTb + (size_t)((b * NH + h) * HD) * LSEQ) + (size_t)(tid >> 3) * (LSEQ * 2) + (tid & 7) * 16;
    const int ldsKw = (tid >> 4) * 272 + (tid & 15) * 16, ldsVw = (tid >> 3) * 144 + (tid & 7) * 16;
    v4u kr0, kr1, vr0, vr1;
    const int kt_last = 2 * qb + 2;
#define A_LOADG(kt_) do { const unsigned char* kp_ = Kg + (size_t)(kt_) * (64 * 2048); kr0 = *(const v4u*)kp_; kr1 = *(const v4u*)(kp_ + 32 * 2048); \
        const unsigned char* vp_ = Vg + (size_t)(kt_) * 128; vr0 = *(const v4u*)vp_; vr1 = *(const v4u*)(vp_ + 64 * (LSEQ * 2)); } while (0)
    f32x4 ckn[4];
#define C_LOADG(kt_) do { if (TYPE == 0) { _Pragma("unroll") for (int j_ = 0; j_ < 4; ++j_) ckn[j_] = *(const f32x4*)(c2row + 64 * (kt_) + 16 * j_ + 4 * fq); } } while (0)
    C_LOADG(kt_last); A_LOADG(kt_last);
    for (int kt = kt_last; kt >= 0; --kt) {
        *(LAS v4u*)(ldsK + ldsKw) = kr0; *(LAS v4u*)(ldsK + ldsKw + 32 * 272) = kr1;
        *(LAS v4u*)(ldsV + ldsVw) = vr0; *(LAS v4u*)(ldsV + ldsVw + 64 * 144) = vr1;
        f32x4 ck[4];
        if (TYPE == 0) {
#pragma unroll
            for (int j = 0; j < 4; ++j) ck[j] = ckn[j];
        }
        __syncthreads();
        if (kt > 0) { C_LOADG(kt - 1); A_LOADG(kt - 1); }
        const int kbase = 64 * kt;
        const bool skip = TYPE == 0 ? (kbase > qmax) : ((kbase >= qmax) || __all(R < -104.0f));
        if (!skip) {
            f32x4 s[4];
#pragma unroll
            for (int j = 0; j < 4; ++j) { s[j] = (f32x4){0.f, 0.f, 0.f, 0.f}; if (TYPE == 0) s[j] = cq - ck[j];
#pragma unroll
                for (int kk = 0; kk < 4; ++kk) { const bf16x8 kf = *(const LAS bf16x8*)(ldsK + (16 * j + fr) * 272 + kk * 64 + fq * 16);
                    s[j] = __builtin_amdgcn_mfma_f32_16x16x32_bf16(kf, qf[kk], s[j], 0, 0, 0); } }
            const bool need_mask = (kt == 0) || (kbase + 63 >= qmin);
            if (TYPE == 0) {
                if (need_mask) {
                    asm volatile("; masked tile");
#pragma unroll
                    for (int j = 0; j < 4; ++j)
#pragma unroll
                        for (int i = 0; i < 4; ++i) { const int kp = kbase + 16 * j + 4 * fq + i; const bool valid = (kp <= qpos) && (kt > 0 || kp < NMETA); s[j][i] = valid ? s[j][i] : -INFINITY; }
                }
                float mx = -INFINITY;
#pragma unroll
                for (int j = 0; j < 4; ++j) mx = fmaxf(mx, fmaxf(fmaxf(s[j][0], s[j][1]), fmaxf(s[j][2], s[j][3])));
                mx = fmaxf(mx, __shfl_xor(mx, 16)); mx = fmaxf(mx, __shfl_xor(mx, 32));
                const float mnew = fmaxf(m_run, mx), alpha = __builtin_amdgcn_exp2f(m_run - mnew); m_run = mnew;
                float ps = 0.f;
#pragma unroll
                for (int j = 0; j < 4; ++j)
#pragma unroll
                    for (int i = 0; i < 4; ++i) { const float p = __builtin_amdgcn_exp2f(s[j][i] - mnew); ps += p; s[j][i] = p; }
                l_run = l_run * alpha + ps;
                if (__any(alpha != 1.0f)) {
#pragma unroll
                    for (int n = 0; n < 8; ++n) o[n] = o[n] * alpha;
                }
            } else {
                const float SC = 0.08838834764831845f;
                float T[4], hi[4], TT[4];
                f32x4 lbv[4];
#pragma unroll
                for (int j = 0; j < 4; ++j) { float tj = 0.f;
#pragma unroll
                    for (int i = 0; i < 4; ++i) { const float z = s[j][i] * SC; const float e = __expf(-fabsf(z)); const float sp = fmaxf(z, 0.f) + __logf(1.0f + e);
                        bool valid = true; if (need_mask) { const int kp = kbase + 16 * j + 4 * fq + i; valid = (kp < qpos) && (kt > 0 || kp < NMETA); }
                        const float lom = valid ? -sp : 0.f; lbv[j][i] = valid ? (z - sp) : -INFINITY; s[j][i] = lom; tj += lom; }
                    T[j] = tj; }
#pragma unroll
                for (int j = 0; j < 4; ++j) { const float a1 = __shfl_xor(T[j], 16), a2 = __shfl_xor(T[j], 32), a3 = __shfl_xor(T[j], 48);
                    hi[j] = fq == 0 ? (a1 + a2 + a3) : (fq == 1 ? (a2 + a3) : (fq == 2 ? a1 : 0.f)); TT[j] = T[j] + a1 + a2 + a3; }
                float run = R;
#pragma unroll
                for (int j = 3; j >= 0; --j) { float tt = run + hi[j];
                    const float w3 = __expf(lbv[j][3] + tt); tt += s[j][3];
                    const float w2 = __expf(lbv[j][2] + tt); tt += s[j][2];
                    const float w1 = __expf(lbv[j][1] + tt); tt += s[j][1];
                    const float w0 = __expf(lbv[j][0] + tt);
                    s[j] = (f32x4){w0, w1, w2, w3}; run += TT[j]; }
                R = run;
            }
            bf16x8 pb[2];
#pragma unroll
            for (int k2 = 0; k2 < 2; ++k2) { v4u w; w.x = pk2(s[2 * k2][0], s[2 * k2][1]); w.y = pk2(s[2 * k2][2], s[2 * k2][3]);
                w.z = pk2(s[2 * k2 + 1][0], s[2 * k2 + 1][1]); w.w = pk2(s[2 * k2 + 1][2], s[2 * k2 + 1][3]); pb[k2] = __builtin_bit_cast(bf16x8, w); }
#pragma unroll
            for (int n = 0; n < 8; ++n)
#pragma unroll
                for (int k2 = 0; k2 < 2; ++k2) { const LAS unsigned char* vp = ldsV + (16 * n + fr) * 144 + k2 * 64 + fq * 8;
                    const v2u a = *(const LAS v2u*)vp, c = *(const LAS v2u*)(vp + 32); const v4u vv = (v4u){a.x, a.y, c.x, c.y};
                    o[n] = __builtin_amdgcn_mfma_f32_16x16x32_bf16(__builtin_bit_cast(bf16x8, vv), pb[k2], o[n], 0, 0, 0); }
        }
        if (TYPE == 1) { const int dn = __all(R < -104.0f) ? 1 : 0; if (lane == 0) flags[wave] = dn; }
        __syncthreads();
        if (TYPE == 1) { const int f = lane < 8 ? flags[lane] : 1; if (__all(f != 0)) break; }
    }
#undef A_LOADG
#undef C_LOADG
    if (TYPE == 0) { float l = l_run + __shfl_xor(l_run, 16); l += __shfl_xor(l, 32); const float inv = 1.0f / l;
#pragma unroll
        for (int n = 0; n < 8; ++n) o[n] = o[n] * inv; }
    bf16* orow = Ob + (size_t)(b * SEQ + tq) * HW + h * HD + 4 * fq;
#pragma unroll
    for (int n = 0; n < 8; ++n) { v2u w; w.x = pk2(o[n][0], o[n][1]); w.y = pk2(o[n][2], o[n][3]); *(v2u*)(orow + 16 * n) = w; }
}


__device__ __forceinline__ void fox_sp_unit(LAS unsigned char* lds, const bf16* Qb, const bf16* Kb, const bf16* VTb, const float* c2, bf16* Ob, int b, int h, int qb, int tid, int wave, int lane) {
    constexpr int KB = 17664, V0 = 2 * KB, VB = 18432;
    const int fr = lane & 15, fq = lane >> 4;
    const int t0 = qb * 128, tq = t0 + wave * 16 + fr, qpos = 64 + tq;
    const int qmin = 64 + t0 + wave * 16, qmax = qmin + 15;
    const bf16* qrow = Qb + (size_t)(b * SEQ + tq) * HW + h * HD + fq * 8;
    bf16x8 qf[4];
#pragma unroll
    for (int kk = 0; kk < 4; ++kk) qf[kk] = *(const bf16x8*)(qrow + 32 * kk);
    f32x4 o[8];
#pragma unroll
    for (int n = 0; n < 8; ++n) o[n] = (f32x4){0.f, 0.f, 0.f, 0.f};
    float m_run = -INFINITY, l_run = 0.f;
    const float* c2row = c2 + (size_t)(b * NH + h) * LSEQ;
    const float cq = c2row[qpos];
    const unsigned char* Kg = (const unsigned char*)(Kb + (size_t)(b * LSEQ) * HW + h * HD) + (size_t)(tid >> 4) * 2048 + (tid & 15) * 16;
    const unsigned char* Vg = (const unsigned char*)(VTb + (size_t)((b * NH + h) * HD) * LSEQ) + (size_t)(tid >> 3) * (LSEQ * 2) + (tid & 7) * 16;
    const int ldsKw = (tid >> 4) * 272 + (tid & 15) * 16, ldsVw = (tid >> 3) * 144 + (tid & 7) * 16;
    v4u kr0, kr1, vr0, vr1; f32x4 cr;
#define SP_LOADK(kt_) do { cr = *(const f32x4*)(c2row + 64 * (kt_) + 4 * (tid & 15)); const unsigned char* kp_ = Kg + (size_t)(kt_) * (64 * 2048); kr0 = *(const v4u*)kp_; kr1 = *(const v4u*)(kp_ + 32 * 2048); } while (0)
#define SP_LOADV(kt_) do { const unsigned char* vp_ = Vg + (size_t)(kt_) * 128; vr0 = *(const v4u*)vp_; vr1 = *(const v4u*)(vp_ + 64 * (LSEQ * 2)); } while (0)
#define SP_STOREK(kt_) do { LAS unsigned char* w_ = lds + ((kt_) & 1) * KB; *(LAS v4u*)(w_ + ldsKw) = kr0; *(LAS v4u*)(w_ + ldsKw + 32 * 272) = kr1; if (tid < 16) *(LAS f32x4*)(w_ + 17408 + tid * 16) = cr; } while (0)
#define SP_STOREV(kt_) do { LAS unsigned char* w_ = lds + V0 + ((kt_) & 1) * VB; *(LAS v4u*)(w_ + ldsVw) = vr0; *(LAS v4u*)(w_ + ldsVw + 64 * 144) = vr1; } while (0)
#define SP_QK(dst, bi_) do { const LAS unsigned char* kb_ = lds + (bi_) * KB; _Pragma("unroll") for (int j = 0; j < 4; ++j) { const f32x4 ck_ = *(const LAS f32x4*)(kb_ + 17408 + (16 * j + 4 * fq) * 4); dst[j] = cq - ck_; \
        _Pragma("unroll") for (int kk = 0; kk < 4; ++kk) { const bf16x8 kf_ = *(const LAS bf16x8*)(kb_ + (16 * j + fr) * 272 + kk * 64 + fq * 16); dst[j] = __builtin_amdgcn_mfma_f32_16x16x32_bf16(kf_, qf[kk], dst[j], 0, 0, 0); } } } while (0)
    const int T = 2 * qb + 2;
    SP_LOADK(T); SP_LOADV(T); SP_STOREK(T); SP_STOREV(T);
    SP_LOADK(T - 1); SP_STOREK(T - 1);
    SP_LOADK(T - 2); SP_LOADV(T - 1);
    __syncthreads();
    f32x4 s_cur[4];
    SP_QK(s_cur, T & 1);
    __syncthreads();
    for (int t = T; t >= 0; --t) {
        if (t >= 1) SP_STOREV(t - 1);
        if (t >= 2) SP_STOREK(t - 2);
        if (t >= 2) SP_LOADV(t - 2);
        if (t >= 3) SP_LOADK(t - 3);
        const int kbase = 64 * t;
        f32x4 s_nxt[4];
        SP_QK(s_nxt, (t + 1) & 1);
        asm volatile("" ::: "memory");
        if (kbase <= qmax) {
            if ((t == 0) || (kbase + 63 >= qmin)) {
                asm volatile("; masked tile");
#pragma unroll
                for (int j = 0; j < 4; ++j)
#pragma unroll
                    for (int i = 0; i < 4; ++i) { const int kp = kbase + 16 * j + 4 * fq + i; const bool valid = (kp <= qpos) && (t > 0 || kp < NMETA); s_cur[j][i] = valid ? s_cur[j][i] : -INFINITY; }
            }
            float mx = -INFINITY;
#pragma unroll
            for (int j = 0; j < 4; ++j) mx = fmaxf(mx, fmaxf(fmaxf(s_cur[j][0], s_cur[j][1]), fmaxf(s_cur[j][2], s_cur[j][3])));
            mx = fmaxf(mx, __shfl_xor(mx, 16)); mx = fmaxf(mx, __shfl_xor(mx, 32));
            const float mnew = fmaxf(m_run, mx), alpha = __builtin_amdgcn_exp2f(m_run - mnew); m_run = mnew;
            float ps = 0.f;
#pragma unroll
            for (int j = 0; j < 4; ++j)
#pragma unroll
                for (int i = 0; i < 4; ++i) { const float p = __builtin_amdgcn_exp2f(s_cur[j][i] - mnew); ps += p; s_cur[j][i] = p; }
            l_run = l_run * alpha + ps;
            if (__any(alpha != 1.0f)) {
#pragma unroll
                for (int n = 0; n < 8; ++n) o[n] = o[n] * alpha;
            }
            bf16x8 pb[2];
#pragma unroll
            for (int k2 = 0; k2 < 2; ++k2) { v4u w; w.x = pk2(s_cur[2 * k2][0], s_cur[2 * k2][1]); w.y = pk2(s_cur[2 * k2][2], s_cur[2 * k2][3]);
                w.z = pk2(s_cur[2 * k2 + 1][0], s_cur[2 * k2 + 1][1]); w.w = pk2(s_cur[2 * k2 + 1][2], s_cur[2 * k2 + 1][3]); pb[k2] = __builtin_bit_cast(bf16x8, w); }
            const LAS unsigned char* vb = lds + V0 + (t & 1) * VB;
#pragma unroll
            for (int n = 0; n < 8; ++n)
#pragma unroll
                for (int k2 = 0; k2 < 2; ++k2) { const LAS unsigned char* vp = vb + (16 * n + fr) * 144 + k2 * 64 + fq * 8;
                    const v2u a = *(const LAS v2u*)vp, c = *(const LAS v2u*)(vp + 32); const v4u vv = (v4u){a.x, a.y, c.x, c.y};
                    o[n] = __builtin_amdgcn_mfma_f32_16x16x32_bf16(__builtin_bit_cast(bf16x8, vv), pb[k2], o[n], 0, 0, 0); }
        }
        __syncthreads();
#pragma unroll
        for (int j = 0; j < 4; ++j) s_cur[j] = s_nxt[j];
    }
#undef SP_LOADK
#undef SP_LOADV
#undef SP_STOREK
#undef SP_STOREV
#undef SP_QK
    float l = l_run + __shfl_xor(l_run, 16); l += __shfl_xor(l, 32); const float inv = 1.0f / l;
    bf16* orow = Ob + (size_t)(b * SEQ + tq) * HW + h * HD + 4 * fq;
#pragma unroll
    for (int n = 0; n < 8; ++n) { const f32x4 r = o[n] * inv; v2u w; w.x = pk2(r[0], r[1]); w.y = pk2(r[2], r[3]); *(v2u*)(orow + 16 * n) = w; }
}


__device__ __forceinline__ void fox_sp32_unit(LAS unsigned char* lds, const bf16* Qb, const bf16* Kb, const bf16* VTb, const float* c2, bf16* Ob, int b, int h, int qb, int tid, int wave, int lane) {
    constexpr int KB = 17664, V0 = 2 * KB, VB = 18432, MRG = 73728;
    const int fr = lane & 15, fq = lane >> 4, rg = wave & 3, kh = wave >> 2;
    LAS f32x4* mrg = (LAS f32x4*)(lds + MRG);
    const int t0 = qb * 128, tq0 = t0 + rg * 32 + fr;
    const int qmin = 64 + t0 + rg * 32, qmax = qmin + 31;
    bf16x8 qf[2][4];
#pragma unroll
    for (int q2 = 0; q2 < 2; ++q2) { const bf16* qrow = Qb + (size_t)(b * SEQ + tq0 + 16 * q2) * HW + h * HD + fq * 8;
#pragma unroll
        for (int kk = 0; kk < 4; ++kk) qf[q2][kk] = *(const bf16x8*)(qrow + 32 * kk); }
    f32x4 o[2][8];
#pragma unroll
    for (int q2 = 0; q2 < 2; ++q2)
#pragma unroll
        for (int n = 0; n < 8; ++n) o[q2][n] = (f32x4){0.f, 0.f, 0.f, 0.f};
    float m_run[2] = {-INFINITY, -INFINITY}, l_run[2] = {0.f, 0.f};
    const float* c2row = c2 + (size_t)(b * NH + h) * LSEQ;
    float cq[2]; cq[0] = c2row[64 + tq0]; cq[1] = c2row[64 + tq0 + 16];
    const unsigned char* Kg = (const unsigned char*)(Kb + (size_t)(b * LSEQ) * HW + h * HD) + (size_t)(tid >> 4) * 2048 + (tid & 15) * 16;
    const unsigned char* Vg = (const unsigned char*)(VTb + (size_t)((b * NH + h) * HD) * LSEQ) + (size_t)(tid >> 3) * (LSEQ * 2) + (tid & 7) * 16;
    const int ldsKw = (tid >> 4) * 272 + (tid & 15) * 16, ldsVw = (tid >> 3) * 144 + (tid & 7) * 16;
    v4u kr0, kr1, vr0, vr1; f32x4 cr;
#define SP_LOADK(kt_) do { cr = *(const f32x4*)(c2row + 64 * (kt_) + 4 * (tid & 15)); const unsigned char* kp_ = Kg + (size_t)(kt_) * (64 * 2048); kr0 = *(const v4u*)kp_; kr1 = *(const v4u*)(kp_ + 32 * 2048); } while (0)
#define SP_LOADV(kt_) do { const unsigned char* vp_ = Vg + (size_t)(kt_) * 128; vr0 = *(const v4u*)vp_; vr1 = *(const v4u*)(vp_ + 64 * (LSEQ * 2)); } while (0)
#define SP_STOREK(kt_) do { LAS unsigned char* w_ = lds + ((kt_) & 1) * KB; *(LAS v4u*)(w_ + ldsKw) = kr0; *(LAS v4u*)(w_ + ldsKw + 32 * 272) = kr1; if (tid < 16) *(LAS f32x4*)(w_ + 17408 + tid * 16) = cr; } while (0)
#define SP_STOREV(kt_) do { LAS unsigned char* w_ = lds + V0 + ((kt_) & 1) * VB; *(LAS v4u*)(w_ + ldsVw) = vr0; *(LAS v4u*)(w_ + ldsVw + 64 * 144) = vr1; } while (0)
#define SP_QK(dst, bi_) do { const LAS unsigned char* kb_ = lds + (bi_) * KB; _Pragma("unroll") for (int jb = 0; jb < 2; ++jb) { const f32x4 ck_ = *(const LAS f32x4*)(kb_ + 17408 + (32 * kh + 16 * jb + 4 * fq) * 4); dst[jb][0] = cq[0] - ck_; dst[jb][1] = cq[1] - ck_; \
        _Pragma("unroll") for (int kk = 0; kk < 4; ++kk) { const bf16x8 kf_ = *(const LAS bf16x8*)(kb_ + (32 * kh + 16 * jb + fr) * 272 + kk * 64 + fq * 16); \
            dst[jb][0] = __builtin_amdgcn_mfma_f32_16x16x32_bf16(kf_, qf[0][kk], dst[jb][0], 0, 0, 0); dst[jb][1] = __builtin_amdgcn_mfma_f32_16x16x32_bf16(kf_, qf[1][kk], dst[jb][1], 0, 0, 0); } } } while (0)
    const int T = 2 * qb + 2;
    SP_LOADK(T); SP_LOADV(T); SP_STOREK(T); SP_STOREV(T);
    SP_LOADK(T - 1); SP_STOREK(T - 1);
    SP_LOADK(T - 2); SP_LOADV(T - 1);
    __syncthreads();
    f32x4 s_cur[2][2];
    SP_QK(s_cur, T & 1);
    __syncthreads();
    for (int t = T; t >= 0; --t) {
        if (t >= 1) SP_STOREV(t - 1);
        if (t >= 2) SP_STOREK(t - 2);
        if (t >= 2) SP_LOADV(t - 2);
        if (t >= 3) SP_LOADK(t - 3);
        const int kb0 = 64 * t + 32 * kh;
        f32x4 s_nxt[2][2];
        SP_QK(s_nxt, (t + 1) & 1);
        asm volatile("" ::: "memory");
        if (!((kb0 > qmax) || (t == 0 && kh == 1))) {
            if ((t == 0) || (kb0 + 31 > qmin)) {
                asm volatile("; masked tile");
#pragma unroll
                for (int q2 = 0; q2 < 2; ++q2)
#pragma unroll
                    for (int jb = 0; jb < 2; ++jb)
#pragma unroll
                        for (int i = 0; i < 4; ++i) { const int kp = kb0 + 16 * jb + 4 * fq + i; const bool valid = (kp <= qmin + 16 * q2 + fr) && (t > 0 || kp < NMETA); s_cur[jb][q2][i] = valid ? s_cur[jb][q2][i] : -INFINITY; }
            }
            float alpha[2];
#pragma unroll
            for (int q2 = 0; q2 < 2; ++q2) {
                float mx = fmaxf(fmaxf(fmaxf(s_cur[0][q2][0], s_cur[0][q2][1]), fmaxf(s_cur[0][q2][2], s_cur[0][q2][3])), fmaxf(fmaxf(s_cur[1][q2][0], s_cur[1][q2][1]), fmaxf(s_cur[1][q2][2], s_cur[1][q2][3])));
                mx = fmaxf(mx, __shfl_xor(mx, 16)); mx = fmaxf(mx, __shfl_xor(mx, 32));
                const float mnew = fmaxf(m_run[q2], mx); alpha[q2] = __builtin_amdgcn_exp2f(m_run[q2] - mnew); m_run[q2] = mnew;
                float ps = 0.f;
#pragma unroll
                for (int jb = 0; jb < 2; ++jb)
#pragma unroll
                    for (int i = 0; i < 4; ++i) { const float p = __builtin_amdgcn_exp2f(s_cur[jb][q2][i] - mnew); ps += p; s_cur[jb][q2][i] = p; }
                l_run[q2] = l_run[q2] * alpha[q2] + ps;
            }
            if (__any((alpha[0] != 1.0f) || (alpha[1] != 1.0f))) {
#pragma unroll
                for (int n = 0; n < 8; ++n) { o[0][n] = o[0][n] * alpha[0]; o[1][n] = o[1][n] * alpha[1]; }
            }
            bf16x8 pb[2];
#pragma unroll
            for (int q2 = 0; q2 < 2; ++q2) { v4u w; w.x = pk2(s_cur[0][q2][0], s_cur[0][q2][1]); w.y = pk2(s_cur[0][q2][2], s_cur[0][q2][3]);
                w.z = pk2(s_cur[1][q2][0], s_cur[1][q2][1]); w.w = pk2(s_cur[1][q2][2], s_cur[1][q2][3]); pb[q2] = __builtin_bit_cast(bf16x8, w); }
            const LAS unsigned char* vb = lds + V0 + (t & 1) * VB;
#pragma unroll
            for (int n = 0; n < 8; ++n) { const LAS unsigned char* vp = vb + (16 * n + fr) * 144 + kh * 64 + fq * 8;
                const v2u a = *(const LAS v2u*)vp, c = *(const LAS v2u*)(vp + 32); const v4u vv = (v4u){a.x, a.y, c.x, c.y}; const bf16x8 vf = __builtin_bit_cast(bf16x8, vv);
                o[0][n] = __builtin_amdgcn_mfma_f32_16x16x32_bf16(vf, pb[0], o[0][n], 0, 0, 0);
                o[1][n] = __builtin_amdgcn_mfma_f32_16x16x32_bf16(vf, pb[1], o[1][n], 0, 0, 0); }
        }
        __syncthreads();
#pragma unroll
        for (int jb = 0; jb < 2; ++jb) { s_cur[jb][0] = s_nxt[jb][0]; s_cur[jb][1] = s_nxt[jb][1]; }
    }
#undef SP_LOADK
#undef SP_LOADV
#undef SP_STOREK
#undef SP_STOREV
#undef SP_QK
    if (kh == 1) {
#pragma unroll
        for (int q2 = 0; q2 < 2; ++q2)
#pragma unroll
            for (int n = 0; n < 8; ++n) mrg[(rg * 17 + q2 * 8 + n) * 64 + lane] = o[q2][n];
        mrg[(rg * 17 + 16) * 64 + lane] = (f32x4){m_run[0], m_run[1], l_run[0], l_run[1]};
    }
    __syncthreads();
    if (kh == 0) {
        const f32x4 st = mrg[(rg * 17 + 16) * 64 + lane];
#pragma unroll
        for (int q2 = 0; q2 < 2; ++q2) {
            const float m1 = q2 ? st.y : st.x, l1 = q2 ? st.w : st.z;
            const float m = fmaxf(m_run[q2], m1), e0 = __builtin_amdgcn_exp2f(m_run[q2] - m), e1 = __builtin_amdgcn_exp2f(m1 - m);
            float l = l_run[q2] * e0 + l1 * e1; l += __shfl_xor(l, 16); l += __shfl_xor(l, 32);
            const float inv = 1.0f / l, w0 = e0 * inv, w1 = e1 * inv;
            bf16* orow = Ob + (size_t)(b * SEQ + tq0 + 16 * q2) * HW + h * HD + 4 * fq;
#pragma unroll
            for (int n = 0; n < 8; ++n) { const f32x4 o1 = mrg[(rg * 17 + q2 * 8 + n) * 64 + lane]; const f32x4 r = o[q2][n] * w0 + o1 * w1;
                v2u w; w.x = pk2(r[0], r[1]); w.y = pk2(r[2], r[3]); *(v2u*)(orow + 16 * n) = w; }
        }
    }
    __syncthreads();
}

#define XB_TMO      128
#define XB_XCNT(j)  (256  + 64 * (j))
#define XB_XSUB(j)  (1280 + 64 * (j))
#define XB_XGEN(j)  (2304 + 64 * (j))
#define XB_TOP      3328
#define XB_TOPGEN   3392
#define XCD_BAR_WORDS 3456
#define XB_SPIN_CAP (1u << 18)

__device__ __forceinline__ unsigned xb_ld(unsigned* p)              { return __hip_atomic_load(p, __ATOMIC_RELAXED, __HIP_MEMORY_SCOPE_AGENT); }
__device__ __forceinline__ unsigned xb_add(unsigned* p, unsigned v) { return __hip_atomic_fetch_add(p, v, __ATOMIC_RELAXED, __HIP_MEMORY_SCOPE_AGENT); }
__device__ __forceinline__ unsigned xb_xcc_id() { return (unsigned)__builtin_amdgcn_s_getreg((3 << 11) | 20) & 0xFu; }
#define XB_SPIN(cond, bar) do { unsigned _sp = 0; while (cond) { __builtin_amdgcn_s_sleep(1); \
    if ((++_sp & 255u) == 0u) { if (xb_ld(&(bar)[XB_TMO])) break; if (_sp > XB_SPIN_CAP) { atomicAdd(&(bar)[XB_TMO], 1u); break; } } } } while (0)

struct XcdBarrier {
    unsigned* bar; unsigned x;
    volatile LAS unsigned* st;
};

__device__ __forceinline__ XcdBarrier xcd_barrier_post(unsigned* bar, volatile LAS unsigned* st) {
    XcdBarrier b; b.bar = bar; b.x = xb_xcc_id(); b.st = st;
    if (threadIdx.x == 0) (void)xb_add(&bar[XB_XCNT(b.x)], 1u);
    return b;
}
__device__ __forceinline__ void xcd_barrier_complete(unsigned* bar, unsigned x, unsigned& nloc, unsigned& nx) {
    const unsigned G = gridDim.x * gridDim.y * gridDim.z;
    unsigned sum, cnt, mine, sp = 0u;
    for (;;) {
        sum = 0u; cnt = 0u; mine = 0u;
#pragma unroll
        for (unsigned j = 0; j < 16; ++j) { const unsigned c = xb_ld(&bar[XB_XCNT(j)]); sum += c; cnt += (c > 0u) ? 1u : 0u; mine = (j == x) ? c : mine; }
        if (sum == G) break;
        __builtin_amdgcn_s_sleep(1);
        if ((++sp & 255u) == 0u) { if (xb_ld(&bar[XB_TMO])) break; if (sp > XB_SPIN_CAP) { atomicAdd(&bar[XB_TMO], 1u); break; } }
    }
    nloc = mine > 0u ? mine : 1u; nx = cnt > 0u ? cnt : 1u;
}

__device__ __forceinline__ void xcd_barrier(const XcdBarrier& b) {
    asm volatile("s_waitcnt vmcnt(0)" ::: "memory");
    __syncthreads();
    if (threadIdx.x == 0) {
        unsigned* bar = b.bar;
        __builtin_amdgcn_s_waitcnt(0);
        unsigned nloc = b.st[0], nx = b.st[1];
        if (nloc == 0u) { xcd_barrier_complete(bar, b.x, nloc, nx); b.st[0] = nloc; b.st[1] = nx; }
        const unsigned old = xb_add(&bar[XB_XSUB(b.x)], 1u);
        const unsigned gen = old / nloc;
        if (old + 1u == (gen + 1u) * nloc) {
            __builtin_amdgcn_fence(__ATOMIC_RELEASE, "agent");
            asm volatile("s_waitcnt vmcnt(0)" ::: "memory");
            const unsigned og = xb_add(&bar[XB_TOP], 1u);
            const unsigned tg = og / nx;
            if (og + 1u == (tg + 1u) * nx) xb_add(&bar[XB_TOPGEN], 1u);
            else XB_SPIN(xb_ld(&bar[XB_TOPGEN]) == tg, bar);
            __builtin_amdgcn_fence(__ATOMIC_ACQUIRE, "agent");
            xb_add(&bar[XB_XGEN(b.x)], 1u);
            asm volatile("s_waitcnt vmcnt(0)" ::: "memory");
        } else {
            XB_SPIN(xb_ld(&bar[XB_XGEN(b.x)]) == gen, bar);
            __builtin_amdgcn_fence(__ATOMIC_ACQUIRE, "agent");
            asm volatile("s_waitcnt vmcnt(0)" ::: "memory");
        }
    }
    __syncthreads();
}

struct Args { const float* in[18]; float* out; unsigned char* ws; int ph_lo, ph_hi; };

__global__ void __launch_bounds__(512, 2) mk_fwd(Args a) {
    extern __shared__ __attribute__((aligned(16))) unsigned char lds_raw[];
    LAS unsigned char* lds = (LAS unsigned char*)lds_raw;
    const int tid = threadIdx.x, lane = tid & 63, wave = __builtin_amdgcn_readfirstlane(tid >> 6);
    const int G = gridDim.x, bx = blockIdx.x;
    const int vcu = (G % 8 == 0) ? (bx % 8) * (G / 8) + bx / 8 : bx;
    const int gw = vcu * 8 + wave, NGW = G * 8;
    unsigned char* ws = a.ws;
    const float* x = a.in[0]; const float* meta = a.in[1];
    float* out = a.out;
    bf16* Wgu1 = (bf16*)(ws + WS_WGU1); bf16* Wd1 = (bf16*)(ws + WS_WD1); bf16* Wgu2 = (bf16*)(ws + WS_WGU2); bf16* Wd2 = (bf16*)(ws + WS_WD2);
    bf16* Win = (bf16*)(ws + WS_WIN); bf16* Wbf = (bf16*)(ws + WS_WBF); bf16* Wbs = (bf16*)(ws + WS_WBS); bf16* Wout = (bf16*)(ws + WS_WOUT);
    bf16* XN = (bf16*)(ws + WS_XN); bf16* U = (bf16*)(ws + WS_U); bf16* Gt = (bf16*)(ws + WS_G); bf16* Qb = (bf16*)(ws + WS_Q); bf16* MRG = (bf16*)(ws + WS_MRG);
    bf16* Kb = (bf16*)(ws + WS_K); bf16* VTb = (bf16*)(ws + WS_VT); bf16* Ob = (bf16*)(ws + WS_O);
    float* H1M = (float*)(ws + WS_MISC); float* LOGF = (float*)(ws + WS_MISC + MISC_LOGF); float* C2 = (float*)(ws + WS_MISC + MISC_C2); float* KVM = (float*)(ws + WS_MISC + MISC_KVM);
    const int lo = a.ph_lo, hi = a.ph_hi;
    volatile LAS unsigned* bst = (volatile LAS unsigned*)(lds + LDS_BYTES - 64);
    if (tid < 16) bst[tid] = 0u;
    __syncthreads();
    XcdBarrier xbar = xcd_barrier_post((unsigned*)ws, bst);
    if (lo < 0) cg::this_grid().sync();
#define IN(k) (lo <= (k) && (k) < hi)
#ifndef REP_PH
#define REP_PH -1
#define REP_N 1
#endif
#define REPS(k) for (int rep_ = 0; rep_ < ((k) == REP_PH ? REP_N : 1); ++rep_)
#define SEAM(k) do { if (IN(k) && IN((k) + 1)) xcd_barrier(xbar); } while (0)

    if (IN(0)) REPS(0) {
        LAS float* scr = (LAS float*)(lds + wave * 16640);
        constexpr int I_GU = (DM / 64) * (FF / 64), I_D = (FF / 64) * (DM / 64), I_IN1 = (DM / 64) * (3072 / 64), I_IN2 = (DM / 64) * (7168 / 64), I_BR = (HW / 64) * (DM / 64), I_OUT = (DM / 64) * (DM / 64);
        constexpr int NITEMS = 2 * I_GU;
        for (int it = gw; it < NITEMS; it += NGW) {
            int r = it;
            if (r < I_GU) { tr_seg(a.in[3], FF, DM, FF, 0, Wgu1, 1, 0, r, scr, lane); continue; } r -= I_GU;
            tr_seg(a.in[4], FF, DM, FF, 0, Wgu1, 2, 0, r - 0, scr, lane);
        }
        for (int r = gw; r < MALL; r += NGW) { f32x4 v[8]; const float* src = r < MREAL ? x + (size_t)r * DM : meta + (size_t)(r - MREAL) * DM; rms_row(src, nullptr, 0.f, a.in[2], XN + (size_t)r * DM, lane, v); }
        const int gt = vcu * 512 + tid, NGT = G * 512;
        for (int i = gt; i < NMETA * 4096 / 4; i += NGT) ((f32x4*)KVM)[i] = (f32x4){0.f, 0.f, 0.f, 0.f};
        for (int i = gt; i < NMETA * DM / 4; i += NGT) ((f32x4*)H1M)[i] = (f32x4){0.f, 0.f, 0.f, 0.f};
        for (int i = gt; i < (MPAD - MALL) * DM / 8; i += NGT) ((v4u*)(XN + (size_t)MALL * DM))[i] = (v4u){0u, 0u, 0u, 0u};
        for (int i = gt; i < 4 * 48 * 128; i += NGT) { const int wb = i / (48 * 128), rem = i - wb * (48 * 128);
            *(v4u*)((unsigned char*)Kb + (size_t)(wb >> 1) * KV_STRIDE + ((size_t)((wb & 1) * LSEQ + 16) * HW) * 2 + (size_t)rem * 16) = (v4u){0u, 0u, 0u, 0u}; }
        for (int i = gt; i < 2 * NB * NH * HD * 6; i += NGT) { const int rr = i / 6, c = i - rr * 6; const int wh = rr / (NB * NH * HD), row = rr - wh * (NB * NH * HD);
            *(v4u*)((unsigned char*)VTb + (size_t)wh * KV_STRIDE + ((size_t)row * LSEQ + 16) * 2 + (size_t)c * 16) = (v4u){0u, 0u, 0u, 0u}; }
    }
    SEAM(0);
    if (IN(1)) REPS(1) {
        pg8::Gemm g{XN, Wgu1, MPAD, 2 * FF, DM, 0, 0}; pg8::StaticOrder S; S.init(MPAD, 2 * FF, G, bx);
        EpiSwiglu E{U};
        pg8::gemm_phase<EpiSwiglu, pg8::StaticOrder, true, true>(lds, g, S, E);
        {
            const int rem = S.nwg % G;
            if (rem != 0 && bx >= rem) {
                LAS float* scr = (LAS float*)(lds + wave * 16640);
                constexpr int I_GU = (DM / 64) * (FF / 64);
                constexpr int I_D = (FF / 64) * (DM / 64);
                for (int r = (bx - rem) * 8 + wave; r < I_D + I_GU; r += (G - rem) * 8) {
                    if (r < I_D) tr_seg(a.in[5], DM, FF, DM, 0, Wd1, 0, 0, r, scr, lane); else tr_seg(a.in[15], FF, DM, FF, 0, Wgu2, 1, 0, r - I_D, scr, lane); }
            } else if (rem == 0) {
                LAS float* scr = (LAS float*)(lds + wave * 16640);
                constexpr int I_GU = (DM / 64) * (FF / 64);
                constexpr int I_D = (FF / 64) * (DM / 64);
                for (int r = gw; r < I_D + I_GU; r += NGW) {
                    if (r < I_D) tr_seg(a.in[5], DM, FF, DM, 0, Wd1, 0, 0, r, scr, lane); else tr_seg(a.in[15], FF, DM, FF, 0, Wgu2, 1, 0, r - I_D, scr, lane); }
            }
        }
    }
    SEAM(1);
    if (IN(2)) REPS(2) {
        pg8::Gemm g{U, Wd1, MPAD, DM, FF, 256 * 2, 256 * 2}; DownOrder S; S.S.init(MREAL, DM, G, bx);
        EpiResid E{x, meta, out, H1M, 0.5f, MALL};
        pg8::gemm_phase<EpiResid, DownOrder, true, true>(lds, g, S, E);
        {
            const int rem = (S.S.nwg + 176) % G; constexpr int I_IN1 = (DM / 64) * (3072 / 64);
            LAS float* scr = (LAS float*)(lds + wave * 16640);
            if (rem != 0 && bx >= rem) { for (int r = (bx - rem) * 8 + wave; r < I_IN1; r += (G - rem) * 8) tr_seg(a.in[7], WIN_LD, DM, 3072, 0, Win, 0, 0, r, scr, lane); }
            else if (rem == 0) { for (int r = gw; r < I_IN1; r += NGW) tr_seg(a.in[7], WIN_LD, DM, 3072, 0, Win, 0, 0, r, scr, lane); }
        }
    }
    SEAM(2);
    if (IN(3)) REPS(3) {
        LAS float* wf = (LAS float*)lds;
        for (int i = tid; i < 8 * DM; i += 512) { const int k = i >> 3, j = i & 7; wf[j * DM + k] = a.in[7][(size_t)k * WIN_LD + 3072 + j]; }
        __syncthreads();
        for (int r = gw; r < MALL; r += NGW) {
            f32x4 v[8]; const float* src = r < MREAL ? out + (size_t)r * DM : meta + (size_t)(r - MREAL) * DM;
            rms_row(src, r < MREAL ? nullptr : H1M + (size_t)(r - MREAL) * DM, 0.5f, a.in[6], XN + (size_t)r * DM, lane, v);
            float mine = 0.f;
#pragma unroll
            for (int j = 0; j < 8; ++j) { float p = 0.f;
#pragma unroll
                for (int jj = 0; jj < 8; ++jj) { const f32x4 w = *(const LAS f32x4*)(wf + j * DM + 256 * jj + 4 * lane); p += (v[jj].x * w.x + v[jj].y * w.y) + (v[jj].z * w.z + v[jj].w * w.w); }
                p = wave_sum(p); mine = (lane == j) ? p : mine; }
            if (lane < 8) { const float lf = log_sigmoid_acc(mine + a.in[8][lane]);
                if (r < MREAL) LOGF[((size_t)(r >> 12) * LLOG + NMETA + (r & 4095)) * NH + lane] = lf;
                else { LOGF[((size_t)0 * LLOG + (r - MREAL)) * NH + lane] = lf; LOGF[((size_t)1 * LLOG + (r - MREAL)) * NH + lane] = lf; } }
        }
        __syncthreads();
        {
            constexpr int I_IN2 = (DM / 64) * (7168 / 64); LAS float* scr = (LAS float*)(lds + wave * 16640);
            for (int r = gw; r < I_IN2; r += NGW) tr_seg(a.in[7], WIN_LD, DM, 7168, 3080, Win, 0, 3072, r, scr, lane);
        }
    }
    SEAM(3);
    if (IN(4)) REPS(4) {
        pg8::Gemm g{XN, Win, MPAD, NIN, DM, 256 * 2, 256 * 2}; InprojOrder S; S.S.init(MREAL, NIN, G, bx);
        EpiInproj E{Qb, Kb, VTb, Gt, KVM};
        pg8::gemm_phase<EpiInproj, InprojOrder, true, true>(lds, g, S, E);
        {
            const int rem = (S.S.nwg + 128) % G; constexpr int I_BR = (HW / 64) * (DM / 64), I_OUT = (DM / 64) * (DM / 64);
            LAS float* scr = (LAS float*)(lds + wave * 16640);
            const bool idle = rem != 0 && bx >= rem;
            if (idle || rem == 0) {
                const int r0 = idle ? (bx - rem) * 8 + wave : gw, rs = idle ? (G - rem) * 8 : NGW;
                for (int r = r0; r < 2 * I_BR + I_OUT; r += rs) {
                    if (r < I_BR) tr_seg(a.in[11], DM, HW, DM, 0, Wbf, 0, 0, r, scr, lane);
                    else if (r < 2 * I_BR) tr_seg(a.in[12], DM, HW, DM, 0, Wbs, 0, 0, r - I_BR, scr, lane);
                    else tr_seg(a.in[13], DM, DM, DM, 0, Wout, 0, 0, r - 2 * I_BR, scr, lane); }
            }
        }
    }
    SEAM(4);
    if (IN(5)) REPS(5) {
        for (int r = gw - NB * NH; r >= 0 && r < MREAL + NB * LSEQ; r += NGW - NB * NH) {
            bf16* p; const float* gn;
            if (r < MREAL) { p = Qb + (size_t)r * HW; gn = a.in[9]; }
            else { const int kr = r - MREAL, pos = kr >= LSEQ ? kr - LSEQ : kr; if (pos < 64) continue; p = Kb + (size_t)kr * HW; gn = a.in[10]; }
            const v4u w0 = ((const v4u*)p)[2 * lane], w1 = ((const v4u*)p)[2 * lane + 1];
            float f[16];
            f[0] = bf_lo(w0.x); f[1] = bf_hi(w0.x); f[2] = bf_lo(w0.y); f[3] = bf_hi(w0.y); f[4] = bf_lo(w0.z); f[5] = bf_hi(w0.z); f[6] = bf_lo(w0.w); f[7] = bf_hi(w0.w);
            f[8] = bf_lo(w1.x); f[9] = bf_hi(w1.x); f[10] = bf_lo(w1.y); f[11] = bf_hi(w1.y); f[12] = bf_lo(w1.z); f[13] = bf_hi(w1.z); f[14] = bf_lo(w1.w); f[15] = bf_hi(w1.w);
            float ss = 0.f;
#pragma unroll
            for (int e = 0; e < 16; ++e) ss += f[e] * f[e];
            ss += __shfl_xor(ss, 1); ss += __shfl_xor(ss, 2); ss += __shfl_xor(ss, 4);
            const float rstd = (1.0f / sqrtf(ss * (1.0f / HD) + RMS_EPS)) * (r < MREAL ? 0.08838834764831845f * LOG2E : 1.0f);
#pragma unroll
            for (int e4 = 0; e4 < 4; ++e4) { const f32x4 g4 = ((const f32x4*)gn)[4 * lane + e4];
                f[4 * e4 + 0] *= rstd * g4.x; f[4 * e4 + 1] *= rstd * g4.y; f[4 * e4 + 2] *= rstd * g4.z; f[4 * e4 + 3] *= rstd * g4.w; }
            v4u o0, o1; o0.x = pk2(f[0], f[1]); o0.y = pk2(f[2], f[3]); o0.z = pk2(f[4], f[5]); o0.w = pk2(f[6], f[7]);
            o1.x = pk2(f[8], f[9]); o1.y = pk2(f[10], f[11]); o1.z = pk2(f[12], f[13]); o1.w = pk2(f[14], f[15]);
            ((v4u*)p)[2 * lane] = o0; ((v4u*)p)[2 * lane + 1] = o1;
        }
        for (int it = NGW - 1 - gw; it < NMETA * 4 * NH; it += NGW) {
            const int i = it >> 5, j = (it >> 3) & 3, hh = it & 7, wh = j >> 1;
            const float* src = KVM + (size_t)i * 4096 + j * 1024 + hh * HD + 2 * lane; float v0 = src[0], v1 = src[1];
            if (j == 0) { const float ss = wave_sum(v0 * v0 + v1 * v1); const float rstd = 1.0f / sqrtf(ss * (1.0f / HD) + RMS_EPS); v0 *= rstd * a.in[10][hh * HD + 2 * lane]; v1 *= rstd * a.in[10][hh * HD + 2 * lane + 1]; }
            const unsigned pk = pk2(v0, v1);
            if ((j & 1) == 0) { bf16* kb = Kb + (size_t)wh * (KV_STRIDE / 2); *(unsigned*)(kb + (size_t)i * HW + hh * HD + 2 * lane) = pk; *(unsigned*)(kb + (size_t)(LSEQ + i) * HW + hh * HD + 2 * lane) = pk; }
            else { bf16* vb = VTb + (size_t)wh * (KV_STRIDE / 2);
#pragma unroll
                for (int bb = 0; bb < NB; ++bb) { vb[(size_t)((bb * NH + hh) * HD + 2 * lane) * LSEQ + i] = (bf16)(pk & 0xffffu); vb[(size_t)((bb * NH + hh) * HD + 2 * lane + 1) * LSEQ + i] = (bf16)(pk >> 16); } }
        }
        if (gw < NB * NH) {
            const int b = gw >> 3, h = gw & 7; const float* lf = LOGF + (size_t)b * LLOG * NH + h; float* cr = C2 + (size_t)(b * NH + h) * LSEQ;
            const int l0 = lane * 65; float s = 0.f; float xv[65];
#pragma unroll
            for (int i = 0; i < 65; ++i) { const int li = l0 + i; xv[i] = li < LLOG ? lf[(size_t)li * NH] : 0.f; }
#pragma unroll
            for (int i = 0; i < 65; ++i) s += xv[i];
            float inc = s;
#pragma unroll
            for (int o = 1; o < 64; o <<= 1) { const float t = __shfl_up(inc, o); if (lane >= o) inc += t; }
            float run = inc - s;
#pragma unroll
            for (int i = 0; i < 65; ++i) { const int li = l0 + i; run += xv[i]; if (li < LLOG) cr[li < NMETA ? li : li + 48] = run * LOG2E; }
        }
    }
    SEAM(5);
    if (IN(6)) REPS(6) {
        for (int it = vcu; it < 512; it += G) {
            const int type = it >> 8, p = it & 255, bh = p >> 4, xx = p & 15, b = bh >> 3, h = bh & 7;
            for (int half = 0; half < 2; ++half) { const int qb = half ? xx : 31 - xx;
                if (type == 0) fox_sp32_unit(lds, Qb, Kb, VTb, C2, Ob, b, h, qb, tid, wave, lane);
                else attn_unit<1>(lds, Qb + (size_t)MREAL * HW, Kb + KV_STRIDE / 2, VTb + KV_STRIDE / 2, C2, Ob + (size_t)MREAL * HW, b, h, qb, tid, wave, lane); }
        }
    }
    SEAM(6);
    if (IN(7)) REPS(7) {
        pg8::Gemm g{Ob, Wbf, MREAL, DM, HW, (size_t)MREAL * HW * 2, (size_t)DM * HW * 2}; BranchOrder S; S.S.init(MREAL, DM, G, bx);
        EpiBranch E{Gt, MRG};
        pg8::gemm_phase<EpiBranch, BranchOrder, true, true>(lds, g, S, E);
    }
    SEAM(7);
    if (IN(8)) REPS(8) {
        pg8::Gemm g{MRG, Wout, MREAL, DM, DM, 0, 0}; pg8::StaticOrder S; S.init(MREAL, DM, G, bx);
        EpiResid E{out, out, out, out, 1.0f, MREAL};
        pg8::gemm_phase<EpiResid, pg8::StaticOrder, true, true>(lds, g, S, E);
    }
    SEAM(8);
    if (IN(9)) REPS(9) {
        for (int r = gw; r < MREAL; r += NGW) { f32x4 v[8]; rms_row(out + (size_t)r * DM, nullptr, 0.f, a.in[14], XN + (size_t)r * DM, lane, v); }
        {
            constexpr int I_GU = (DM / 64) * (FF / 64); LAS float* scr = (LAS float*)(lds + wave * 16640);
            for (int r = gw; r < I_GU; r += NGW) tr_seg(a.in[16], FF, DM, FF, 0, Wgu2, 2, 0, r, scr, lane);
        }
    }
    SEAM(9);
    if (IN(10)) REPS(10) {
#ifndef REP_GEMM10
#define REP_GEMM10 1
#endif
#ifndef EXTRA_SYNCS
#define EXTRA_SYNCS 0
#endif
        pg8::Gemm g{XN, Wgu2, MREAL, 2 * FF, DM, 0, 0}; RepOrder<pg8::StaticOrder, REP_GEMM10> S; S.S.init(MREAL, 2 * FF, G, bx); S.count();
        EpiSwiglu E{U};
        pg8::gemm_phase<EpiSwiglu, RepOrder<pg8::StaticOrder, REP_GEMM10>, true, true>(lds, g, S, E);
        {
            const int rem = S.S.nwg % G; constexpr int I_D = (FF / 64) * (DM / 64);
            LAS float* scr = (LAS float*)(lds + wave * 16640);
            if (rem != 0 && bx >= rem) { for (int r = (bx - rem) * 8 + wave; r < I_D; r += (G - rem) * 8) tr_seg(a.in[17], DM, FF, DM, 0, Wd2, 0, 0, r, scr, lane); }
            else if (rem == 0) { for (int r = gw; r < I_D; r += NGW) tr_seg(a.in[17], DM, FF, DM, 0, Wd2, 0, 0, r, scr, lane); }
        }
        for (int es = 0; es < EXTRA_SYNCS; ++es) xcd_barrier(xbar);
    }
    SEAM(10);
    if (IN(11)) REPS(11) {
        pg8::Gemm g{U, Wd2, MREAL, DM, FF, 0, 0}; pg8::StaticOrder S; S.init(MREAL, DM, G, bx);
        EpiResid E{out, out, out, out, 0.5f, MREAL};
        pg8::gemm_phase<EpiResid, pg8::StaticOrder, true, true>(lds, g, S, E);
    }
#undef IN
#undef SEAM
}

extern "C" void kernel_launch(void* const* d_in, const int* in_sizes, int n_in, void* d_out, int out_size, void* d_ws, size_t ws_size, hipStream_t stream) {
    static int grid = 0;
    if (grid == 0) {
        if (n_in != 18 || in_sizes[0] != MREAL * DM || out_size != MREAL * DM || ws_size < WS_END) {
            fprintf(stderr, "kernel_launch: unexpected shapes: n_in %d in0 %d out %d ws %zu (need %zu)\n", n_in, n_in > 0 ? in_sizes[0] : -1, out_size, ws_size, (size_t)WS_END); grid = -1; return; }
        int dev = 0, cus = 0, per_cu = 0;
        if (hipGetDevice(&dev) != hipSuccess || hipDeviceGetAttribute(&cus, hipDeviceAttributeMultiprocessorCount, dev) != hipSuccess) { grid = -1; return; }
        if (hipFuncSetAttribute((const void*)mk_fwd, hipFuncAttributeMaxDynamicSharedMemorySize, LDS_BYTES) != hipSuccess) { fprintf(stderr, "kernel_launch: hipFuncSetAttribute failed\n"); grid = -1; return; }
        if (hipOccupancyMaxActiveBlocksPerMultiprocessor(&per_cu, (const void*)mk_fwd, 512, LDS_BYTES) != hipSuccess || per_cu < 1) { fprintf(stderr, "kernel_launch: occupancy query says %d\n", per_cu); per_cu = 1; }
        (void)hipGetLastError();
        grid = cus * per_cu;
    }
    if (grid < 0) return;
    Args a{};
    for (int i = 0; i < 18; ++i) a.in[i] = (const float*)d_in[i];
    a.out = (float*)d_out; a.ws = (unsigned char*)d_ws;
#if MK_N_LAUNCHES == 1
    if (hipMemsetAsync(d_ws, 0, 16384, stream) != hipSuccess) { fprintf(stderr, "kernel_launch: memset of the barrier words failed\n"); return; }
    a.ph_lo = 0; a.ph_hi = NPHASE;
    void* args[] = {&a};
    hipError_t e = hipLaunchCooperativeKernel((const void*)mk_fwd, dim3(grid), dim3(512), args, LDS_BYTES, stream);
    if (e != hipSuccess) fprintf(stderr, "kernel_launch: cooperative launch failed: %s (grid %d)\n", hipGetErrorString(e), grid);
#else
    for (int p = 0; p < NPHASE; ++p) { a.ph_lo = p; a.ph_hi = p + 1; hipLaunchKernelGGL(mk_fwd, dim3(grid), dim3(512), LDS_BYTES, stream, a); }
#endif
}
```
